# Optimizing an MI355X kernel written in HIP

```python
import jax, jax.numpy as jnp
from jax import lax
import numpy as np

D_MODEL = 1024
BATCH = 4
SEQ = 8192
DEPTH = 2
DEC_BATCH = 8
DEC_SEQ = 32
PAST_LEN = 2048

CHUNK = 64
Q_BLOCK = 128
PLE_DIM = 256
D_FF = 4 * D_MODEL
MLA_HEADS = 8
MLA_NOPE = 64
MLA_ROPE = 32
MLA_V = 64
MLA_Q_LORA = 384
MLA_KV_LORA = 256
MLA_SCALE = (MLA_NOPE + MLA_ROPE) ** -0.5
RET_HEADS = 8
RET_DK = 32
RET_DV = 64
D_MIX = MLA_HEADS * MLA_V + RET_HEADS * RET_DV
ROPE_THETA = 10000.0
EPS = 1e-6
NEG = -1e30
IN_SPLITS = (MLA_Q_LORA, MLA_KV_LORA, MLA_ROPE, RET_HEADS * RET_DK, RET_HEADS * RET_DK,
             RET_HEADS * RET_DV, RET_HEADS * RET_DV)
D_IN = sum(IN_SPLITS)

kernel_name = "hybrid_mla_retention_streaming_step"


def rms_norm(x, w):
    xf = x.astype(jnp.float32)
    y = xf * lax.rsqrt(jnp.mean(xf * xf, axis=-1, keepdims=True) + EPS)
    return (y * w.astype(jnp.float32)).astype(x.dtype)


def rope(x, pos):
    half = x.shape[-1] // 2
    inv = ROPE_THETA ** (-jnp.arange(half, dtype=jnp.float32) / half)
    ang = pos.astype(jnp.float32)[:, None] * inv[None, :]
    if x.ndim == 4:
        ang = ang[:, None, :]
    cos, sin = jnp.cos(ang), jnp.sin(ang)
    xf = x.astype(jnp.float32)
    x1, x2 = xf[..., :half], xf[..., half:]
    return jnp.concatenate([x1 * cos - x2 * sin, x1 * sin + x2 * cos], axis=-1).astype(x.dtype)


def project_mixers(a, pos, w_in, q_norm_w, w_uq, kv_norm_w):
    B, L, _ = a.shape
    offs = np.cumsum(IN_SPLITS)[:-1].tolist()
    q_lat, ckv, krope, rq, rk, rv, rg = jnp.split(a @ w_in, offs, axis=-1)
    q = (rms_norm(q_lat, q_norm_w) @ w_uq).reshape(B, L, MLA_HEADS, MLA_NOPE + MLA_ROPE)
    q_nope = q[..., :MLA_NOPE]
    q_rope = rope(q[..., MLA_NOPE:], pos)
    ckv = rms_norm(ckv, kv_norm_w)
    krope = rope(krope, pos)
    rq = rope(rq.reshape(B, L, RET_HEADS, RET_DK), pos)
    rk = rope(rk.reshape(B, L, RET_HEADS, RET_DK), pos) * (RET_DK ** -0.5)
    rv = rv.reshape(B, L, RET_HEADS, RET_DV)
    return q_nope, q_rope, ckv, krope, rq, rk, rv, rg


def expand_latent(ckv, w_ukv):
    B, L, _ = ckv.shape
    kv = (ckv @ w_ukv).reshape(B, L, MLA_HEADS, MLA_NOPE + MLA_V)
    return kv[..., :MLA_NOPE], kv[..., MLA_NOPE:]


def mla_core(q_nope, q_rope, k_nope, k_rope, v, q_pos, k_pos):
    s = (jnp.einsum('bqhd,bkhd->bhqk', q_nope.astype(jnp.float32), k_nope.astype(jnp.float32))
         + jnp.einsum('bqhr,bkr->bhqk', q_rope.astype(jnp.float32), k_rope.astype(jnp.float32)))
    s = s * MLA_SCALE
    mask = (k_pos // CHUNK)[None, :] <= (q_pos // CHUNK)[:, None]
    p = jax.nn.softmax(jnp.where(mask[None, None], s, NEG), axis=-1)
    return jnp.einsum('bhqk,bkhe->bqhe', p, v.astype(jnp.float32)).astype(v.dtype)


def mla_prompt(q_nope, q_rope, k_nope, k_rope, v, pos):
    B, S = q_nope.shape[:2]
    nb = S // Q_BLOCK
    def blocks(t):
        return t.reshape(B, nb, Q_BLOCK, *t.shape[2:]).swapaxes(0, 1)
    def one_block(args):
        qn, qr, qp = args
        return mla_core(qn, qr, k_nope, k_rope, v, qp, pos)
    out = lax.map(one_block, (blocks(q_nope), blocks(q_rope), pos.reshape(nb, Q_BLOCK)))
    return out.swapaxes(0, 1).reshape(B, S, MLA_HEADS * MLA_V)


def retention_block(q, k, v, state, log_gamma):
    L = q.shape[1]
    qf, kf, vf = q.astype(jnp.float32), k.astype(jnp.float32), v.astype(jnp.float32)
    sf = state.astype(jnp.float32)
    idx = jnp.arange(L, dtype=jnp.float32)
    diff = idx[:, None] - idx[None, :]
    decay = jnp.where(diff >= 0, jnp.exp(jnp.maximum(diff, 0.0)[None] * log_gamma[:, None, None]), 0.0)
    inner = jnp.einsum('bnhd,bmhd->bhnm', qf, kf) * decay[None]
    o = jnp.einsum('bhnm,bmhe->bnhe', inner, vf)
    q_decay = jnp.exp((idx + 1.0)[:, None] * log_gamma[None, :])
    o = o + jnp.einsum('bnhd,bhde->bnhe', qf * q_decay[None, :, :, None], sf)
    k_decay = jnp.exp((L - 1.0 - idx)[:, None] * log_gamma[None, :])
    new_state = (jnp.exp(L * log_gamma)[None, :, None, None] * sf
                 + jnp.einsum('bmhd,bmhe->bhde', kf * k_decay[None, :, :, None], vf))
    return o, new_state


def retention_prompt(q, k, v, log_gamma):
    B, S = q.shape[:2]
    nc = S // CHUNK
    def chunks(t):
        return t.reshape(B, nc, CHUNK, *t.shape[2:]).swapaxes(0, 1)
    def step(st, c):
        qc, kc, vc = c
        o, st = retention_block(qc, kc, vc, st, log_gamma)
        return st, o
    st0 = jnp.zeros((B, RET_HEADS, RET_DK, RET_DV), jnp.float32)
    st, o = lax.scan(step, st0, (chunks(q), chunks(k), chunks(v)))
    return o.swapaxes(0, 1).reshape(B, S, RET_HEADS, RET_DV), st


def retention_out(o, g, gn_w):
    B, L = o.shape[:2]
    mu = jnp.mean(o, axis=-1, keepdims=True)
    var = jnp.mean(jnp.square(o - mu), axis=-1, keepdims=True)
    on = ((o - mu) * lax.rsqrt(var + EPS)).reshape(B, L, RET_HEADS * RET_DV) * gn_w.astype(jnp.float32)
    return (jax.nn.silu(g.astype(jnp.float32)) * on).astype(g.dtype)


def channel_and_ple(h, p_i, norm_ffn_w, w_ff1, w_ff2, norm_ple_w, w_ple_gate, w_ple_proj):
    u = rms_norm(h, norm_ffn_w) @ w_ff1
    h = h + jnp.square(jax.nn.relu(u)) @ w_ff2
    gate = jax.nn.sigmoid(rms_norm(h, norm_ple_w) @ w_ple_gate)
    return h + (p_i @ w_ple_proj) * gate


def setup_inputs(seed: int = 0) -> dict:
    key = jax.random.key(seed)
    ks = jax.random.split(key, 24)
    f32 = jnp.float32
    def nrm(k, shape, scale=1.0):
        return jax.random.normal(k, shape, f32) * scale
    def gain(k, shape):
        return 1.0 + 0.05 * jax.random.normal(k, shape, f32)
    return {
        'x_prompt': nrm(ks[0], (BATCH, SEQ, D_MODEL)),
        'x_sample': nrm(ks[1], (DEC_BATCH, DEC_SEQ, D_MODEL)),
        'cache_ckv': nrm(ks[2], (DEPTH, DEC_BATCH, PAST_LEN, MLA_KV_LORA)),
        'cache_krope': nrm(ks[3], (DEPTH, DEC_BATCH, PAST_LEN, MLA_ROPE)),
        'state_ret': nrm(ks[4], (DEPTH, DEC_BATCH, RET_HEADS, RET_DK, RET_DV)),
        'p_prompt': nrm(ks[5], (DEPTH, BATCH, SEQ, PLE_DIM)),
        'p_sample': nrm(ks[6], (DEPTH, DEC_BATCH, DEC_SEQ, PLE_DIM)),
        'norm_mix_w': gain(ks[7], (DEPTH, D_MODEL)),
        'w_in': nrm(ks[8], (DEPTH, D_MODEL, D_IN), D_MODEL ** -0.5),
        'q_norm_w': gain(ks[9], (DEPTH, MLA_Q_LORA)),
        'w_uq': nrm(ks[10], (DEPTH, MLA_Q_LORA, MLA_HEADS * (MLA_NOPE + MLA_ROPE)), MLA_Q_LORA ** -0.5),
        'kv_norm_w': gain(ks[11], (DEPTH, MLA_KV_LORA)),
        'w_ukv': nrm(ks[12], (DEPTH, MLA_KV_LORA, MLA_HEADS * (MLA_NOPE + MLA_V)), MLA_KV_LORA ** -0.5),
        'ret_gn_w': gain(ks[13], (DEPTH, RET_HEADS * RET_DV)),
        'w_out': nrm(ks[14], (DEPTH, D_MIX, D_MODEL), D_MIX ** -0.5),
        'norm_ffn_w': gain(ks[15], (DEPTH, D_MODEL)),
        'w_ff1': nrm(ks[16], (DEPTH, D_MODEL, D_FF), D_MODEL ** -0.5),
        'w_ff2': nrm(ks[17], (DEPTH, D_FF, D_MODEL), D_FF ** -0.5),
        'norm_ple_w': gain(ks[18], (DEPTH, D_MODEL)),
        'w_ple_gate': nrm(ks[19], (DEPTH, D_MODEL, D_MODEL), D_MODEL ** -0.5),
        'w_ple_proj': nrm(ks[20], (DEPTH, PLE_DIM, D_MODEL), PLE_DIM ** -0.5),
        'final_norm_w': gain(ks[21], (D_MODEL,)),
    }


def reference(x_prompt, x_sample, cache_ckv, cache_krope, state_ret, p_prompt, p_sample,
              norm_mix_w, w_in, q_norm_w, w_uq, kv_norm_w, w_ukv, ret_gn_w, w_out,
              norm_ffn_w, w_ff1, w_ff2, norm_ple_w, w_ple_gate, w_ple_proj, final_norm_w):
    log_gamma = jnp.log1p(-jnp.exp2(-5.0 - jnp.arange(RET_HEADS, dtype=jnp.float32)))
    B, S = x_prompt.shape[:2]
    Bd, Ld = x_sample.shape[:2]
    past = cache_ckv.shape[2]
    pos_p = jnp.arange(S, dtype=jnp.int32)
    pos_s = past + jnp.arange(Ld, dtype=jnp.int32)
    pos_all = jnp.arange(past + Ld, dtype=jnp.int32)

    hp, hs = x_prompt, x_sample
    ckv_p_l, kr_p_l, st_p_l, ckv_s_l, kr_s_l, st_s_l = [], [], [], [], [], []
    for i in range(DEPTH):
        a = rms_norm(hp, norm_mix_w[i])
        qn, qr, ckv, kr, rq, rk, rv, rg = project_mixers(a, pos_p, w_in[i], q_norm_w[i], w_uq[i], kv_norm_w[i])
        k_nope, v = expand_latent(ckv, w_ukv[i])
        att = mla_prompt(qn, qr, k_nope, kr, v, pos_p)
        ret, st = retention_prompt(rq, rk, rv, log_gamma)
        mix = jnp.concatenate([att, retention_out(ret, rg, ret_gn_w[i])], axis=-1)
        hp = hp + mix @ w_out[i]
        hp = channel_and_ple(hp, p_prompt[i], norm_ffn_w[i], w_ff1[i], w_ff2[i],
                             norm_ple_w[i], w_ple_gate[i], w_ple_proj[i])
        ckv_p_l.append(ckv)
        kr_p_l.append(kr)
        st_p_l.append(st.astype(x_prompt.dtype))

        a = rms_norm(hs, norm_mix_w[i])
        qn, qr, ckv, kr, rq, rk, rv, rg = project_mixers(a, pos_s, w_in[i], q_norm_w[i], w_uq[i], kv_norm_w[i])
        ckv_all = jnp.concatenate([cache_ckv[i], ckv], axis=1)
        kr_all = jnp.concatenate([cache_krope[i], kr], axis=1)
        k_nope, v = expand_latent(ckv_all, w_ukv[i])
        att = mla_core(qn, qr, k_nope, kr_all, v, pos_s, pos_all).reshape(Bd, Ld, MLA_HEADS * MLA_V)
        ret, st = retention_block(rq, rk, rv, state_ret[i], log_gamma)
        mix = jnp.concatenate([att, retention_out(ret, rg, ret_gn_w[i])], axis=-1)
        hs = hs + mix @ w_out[i]
        hs = channel_and_ple(hs, p_sample[i], norm_ffn_w[i], w_ff1[i], w_ff2[i],
                             norm_ple_w[i], w_ple_gate[i], w_ple_proj[i])
        ckv_s_l.append(ckv)
        kr_s_l.append(kr)
        st_s_l.append(st.astype(x_sample.dtype))

    y_prompt = rms_norm(hp, final_norm_w)
    y_sample = rms_norm(hs, final_norm_w)
    ckv_prompt = jnp.stack(ckv_p_l)
    krope_prompt = jnp.stack(kr_p_l)
    ret_prompt = jnp.stack(st_p_l)
    ckv_sample = jnp.stack(ckv_s_l)
    krope_sample = jnp.stack(kr_s_l)
    ret_sample = jnp.stack(st_s_l)
    return (y_prompt, y_sample, ckv_prompt, krope_prompt, ret_prompt, ckv_sample, krope_sample, ret_sample)
```

```cpp
#include <hip/hip_runtime.h>
#include <hip/hip_cooperative_groups.h>
#include <cstdio>
#include <cstdint>
#include <cmath>
namespace cg = cooperative_groups;
namespace pg8 {
#define PG8_LAS __attribute__((address_space(3)))
typedef unsigned short bf16_t;
typedef short bf16x8 __attribute__((ext_vector_type(8)));
typedef float f32x4 __attribute__((ext_vector_type(4)));
typedef unsigned u32x4 __attribute__((ext_vector_type(4)));
constexpr int BM = 256, BK = 64, HALF = 128, HTB = HALF * BK * 2  , STAGE_BYTES = 8 * HTB, NXCD = 8, WGM = 8;

__host__ __device__ __forceinline__ int lds_byte(int r, int c) { const int st = (r >> 4) * 2 + (c >> 5), rr = r & 15, cc = c & 31, ob = rr * 64 + cc * 2; return st * 1024 + (ob ^ (((ob >> 9) & 1) << 5)); }
__host__ __device__ __forceinline__ void stage_rc(int b, int& R, int& C) { const int st = b / 1024, sb = b % 1024, swz = sb ^ (((sb >> 9) & 1) << 5); R = (st >> 1) * 16 + swz / 64; C = (st & 1) * 32 + (swz % 64) / 2; }
__host__ __device__ __forceinline__ int perm32(int rho) { const int n = rho >> 4, i = rho & 15; return 8 * (i >> 2) + 4 * n + (i & 3); }

struct Unit { int pm, pn; };
struct Gemm { const bf16_t* A; const bf16_t* Bt; int M, N, K; };

struct StaticOrder {
    int nM, nN, nwg, G, c;
    __host__ __device__ void init(int M, int N, int G_, int c_) { nM = M / BM; nN = N / BM; nwg = nM * nN; G = G_; c = c_; }
    __host__ __device__ bool next(int i, Unit& u) const {
        const long L = (long)i * G + c; if (L >= nwg) return false;
        int wgid = (int)L; { const int q = nwg / NXCD, r = nwg % NXCD, xcd = wgid % NXCD, off = wgid / NXCD; wgid = (xcd < r ? xcd * (q + 1) : r * (q + 1) + (xcd - r) * q) + off; }
        const int nig = WGM * nN, gid = wgid / nig, fm = gid * WGM, gsz = (nM - fm) < WGM ? (nM - fm) : WGM;
        u.pm = fm + ((wgid % nig) % gsz); u.pn = (wgid % nig) / gsz; return true;
    }
    __device__ __forceinline__ void a_ready(const Unit&) const {}
    __device__ __forceinline__ void done(const Unit&) const {}
};

__device__ __forceinline__ unsigned cvt_pk_bf16(float lo, float hi) { unsigned r; asm volatile("v_cvt_pk_bf16_f32 %0, %1, %2" : "=v"(r) : "v"(lo), "v"(hi)); return r; }
typedef float f32x2 __attribute__((ext_vector_type(2)));
__device__ __forceinline__ f32x2 gelu_pk(f32x2 v) {
    const f32x2 av = __builtin_elementwise_abs(v), d = av * 0.2316418882f + 1.0f;
    f32x2 t; t.x = __builtin_amdgcn_rcpf(d.x); t.y = __builtin_amdgcn_rcpf(d.y);
    f32x2 q = t * 0.5307027145f + (-0.7265760135f); q = q * t + 0.7107068705f; q = q * t + (-0.142248368f); q = q * t + 0.127414796f; q = q * t;
    const f32x2 s = (v * v) * (-0.72134752044f);
    f32x2 e; e.x = __builtin_amdgcn_exp2f(s.x); e.y = __builtin_amdgcn_exp2f(s.y);
    const f32x2 m = v * (q * e), r = v - m;
    f32x2 o; o.x = v.x < 0.f ? m.x : r.x; o.y = v.y < 0.f ? m.y : r.y; return o;
}

template <int ACT  > struct EpiBf16 {
    static constexpr bool PERM = true, AFTER_DRAIN = false; static_assert(ACT == 0 || ACT == 1, "EpiBf16: ACT is 0 (none) or 1 (gelu_pk)");
    bf16_t* O; int ldc; const float* bias; int split_cols; size_t split_stride; float scale0;
    __device__ __forceinline__ void operator()(const f32x4 (&acc)[2][2][4][2], const Unit& u, int wr, int wc, int fr, int fq) const {
        const int row0 = u.pm * BM + wr * 64 + fr; int colt = u.pn * BM; bf16_t* base = O;
        float sc = 1.f; if (split_cols) { const int t = colt / split_cols; base += (size_t)t * split_stride; colt -= t * split_cols; if (t == 0) sc = scale0; }
        const int col0 = colt + wc * 32 + 8 * fq, bcol0 = u.pn * BM + wc * 32 + 8 * fq;
        f32x4 bv[2][2];
#pragma unroll
        for (int bj = 0; bj < 2; ++bj)
#pragma unroll
            for (int n = 0; n < 2; ++n) bv[bj][n] = bias ? *(const f32x4*)(bias + bcol0 + bj * HALF + 4 * n) : (f32x4){0.f, 0.f, 0.f, 0.f};
#pragma unroll
        for (int ai = 0; ai < 2; ++ai)
#pragma unroll
            for (int m = 0; m < 4; ++m) { bf16_t* rowp = base + (size_t)(row0 + ai * HALF + m * 16) * ldc + col0;
#pragma unroll
                for (int bj = 0; bj < 2; ++bj) { f32x4 v0 = acc[ai][bj][m][0] + bv[bj][0], v1 = acc[ai][bj][m][1] + bv[bj][1];
                    if (ACT == 1) { f32x2 a = gelu_pk((f32x2){v0[0], v0[1]}), b = gelu_pk((f32x2){v0[2], v0[3]}), c = gelu_pk((f32x2){v1[0], v1[1]}), d = gelu_pk((f32x2){v1[2], v1[3]});
                        v0 = (f32x4){a.x, a.y, b.x, b.y}; v1 = (f32x4){c.x, c.y, d.x, d.y}; }
                    v0 = v0 * sc; v1 = v1 * sc; u32x4 w; w.x = cvt_pk_bf16(v0[0], v0[1]); w.y = cvt_pk_bf16(v0[2], v0[3]); w.z = cvt_pk_bf16(v1[0], v1[1]); w.w = cvt_pk_bf16(v1[2], v1[3]);
                    *(u32x4*)(rowp + bj * HALF) = w; } }
    }
};

struct PanelStats {
    unsigned* xbuf;
    unsigned* cnt;
    unsigned* tmo;
    int ntn; float eps;
    unsigned code;
    __device__ __forceinline__ bool run(const f32x4 (&v)[2][2][4][2], const Unit& u, int wr, int wc, int fr, int fq, PG8_LAS unsigned char* lds, int wid, int lane) const {
        typedef float f32x2v __attribute__((ext_vector_type(2)));
        PG8_LAS f32x2v* P = (PG8_LAS f32x2v*)lds;
        PG8_LAS f32x2v* S = (PG8_LAS f32x2v*)(lds + 8192);
        PG8_LAS unsigned* flag = (PG8_LAS unsigned*)(lds + 8192 + 2048);
#pragma unroll
        for (int ai = 0; ai < 2; ++ai)
#pragma unroll
            for (int m = 0; m < 4; ++m) {
                float s = 0.f;
#pragma unroll
                for (int bj = 0; bj < 2; ++bj)
#pragma unroll
                    for (int n = 0; n < 2; ++n) { const f32x4 x = v[ai][bj][m][n]; s += (x[0] + x[1]) + (x[2] + x[3]); }
                s += __shfl_xor(s, 16); s += __shfl_xor(s, 32);
                const float mw = s * (1.0f / 64.0f); float q = 0.f;
#pragma unroll
                for (int bj = 0; bj < 2; ++bj)
#pragma unroll
                    for (int n = 0; n < 2; ++n) { const f32x4 d = v[ai][bj][m][n] - mw; q += (d[0] * d[0] + d[1] * d[1]) + (d[2] * d[2] + d[3] * d[3]); }
                q += __shfl_xor(q, 16); q += __shfl_xor(q, 32);
                if (fq == 0) P[(ai * HALF + wr * 64 + m * 16 + fr) * 4 + wc] = (f32x2v){mw, q};
            }
        asm volatile("s_waitcnt lgkmcnt(0)" ::: "memory"); __builtin_amdgcn_s_barrier(); asm volatile("" ::: "memory");
#if defined(BROKEN_EXCHANGE_NO_WAIT)
#warning BROKEN CONTROL BUILD: the row-statistics exchange does not wait; results are wrong by design
        if (blockIdx.x >= 64) { const long long t0_ = clock64(); while (clock64() - t0_ < 60000) __builtin_amdgcn_s_sleep(8); }
#endif
        const int row = wid * 32 + (lane & 31);
        if (lane < 32) {
            const f32x2v a = P[row * 4 + 0], b = P[row * 4 + 1], c = P[row * 4 + 2], d = P[row * 4 + 3];
            const float mt = (a.x + b.x + c.x + d.x) * 0.25f;
            const float da = a.x - mt, db = b.x - mt, dc = c.x - mt, dd = d.x - mt;
            const float m2 = (a.y + b.y) + (c.y + d.y) + 64.0f * ((da * da + db * db) + (dc * dc + dd * dd));
            unsigned long long* slot = (unsigned long long*)xbuf + ((size_t)(u.pm * BM + row) * 4 + u.pn);
            __hip_atomic_store(slot, ((unsigned long long)__float_as_uint(m2) << 32) | __float_as_uint(mt), __ATOMIC_RELAXED, __HIP_MEMORY_SCOPE_AGENT);
        }
        asm volatile("s_waitcnt vmcnt(0)" ::: "memory");
        if (lane == 0) __hip_atomic_fetch_add(cnt + 64 * u.pm, 1u, __ATOMIC_RELAXED, __HIP_MEMORY_SCOPE_AGENT);
        if (wid == 0) {
            bool dead = false; const unsigned long long t0 = __builtin_amdgcn_s_memrealtime(); const unsigned want = 8u * (unsigned)ntn;
            for (;;) {
#if defined(BROKEN_EXCHANGE_NO_WAIT)
                break;
#endif
                if ((unsigned)__builtin_amdgcn_readfirstlane(__hip_atomic_load(cnt + 64 * u.pm, __ATOMIC_RELAXED, __HIP_MEMORY_SCOPE_AGENT)) >= want) break;
                if (__builtin_amdgcn_s_memrealtime() - t0 > 2000000ull) {
                    if (lane == 0) { unsigned expect = 0u; __hip_atomic_compare_exchange_strong(tmo + 1, &expect, code | (unsigned)(u.pm & 0xff), __ATOMIC_RELAXED, __ATOMIC_RELAXED, __HIP_MEMORY_SCOPE_AGENT);
                                     __hip_atomic_store(tmo, 1u, __ATOMIC_RELAXED, __HIP_MEMORY_SCOPE_AGENT); }
                    dead = true; break; }
                __builtin_amdgcn_s_sleep(2);
            }
            __builtin_amdgcn_fence(__ATOMIC_ACQUIRE, "agent");
            if (lane == 0) flag[0] = dead ? 1u : 0u;
        }
        asm volatile("s_waitcnt vmcnt(0) lgkmcnt(0)" ::: "memory"); __builtin_amdgcn_s_barrier(); asm volatile("" ::: "memory");
        const bool bad = flag[0] != 0u;
        if (lane < 32) {
            const unsigned long long* slot = (const unsigned long long*)xbuf + (size_t)(u.pm * BM + row) * 4; float mt[4], m2[4]; float ms = 0.f;
#pragma unroll
            for (int t = 0; t < 4; ++t) { if (t < ntn) { const unsigned long long w = __hip_atomic_load(slot + t, __ATOMIC_RELAXED, __HIP_MEMORY_SCOPE_AGENT); mt[t] = __uint_as_float((unsigned)w); m2[t] = __uint_as_float((unsigned)(w >> 32)); } else { mt[t] = 0.f; m2[t] = 0.f; } ms += mt[t]; }
            const float mean = ms / (float)ntn; float q = 0.f;
#pragma unroll
            for (int t = 0; t < 4; ++t) if (t < ntn) { const float dm = mt[t] - mean; q += m2[t] + 256.0f * dm * dm; }
            S[row] = (f32x2v){mean, 1.0f / sqrtf(q / (256.0f * (float)ntn) + eps)};
        }
        asm volatile("s_waitcnt lgkmcnt(0)" ::: "memory"); __builtin_amdgcn_s_barrier(); asm volatile("" ::: "memory");
        return bad;
    }
};
struct EpiLnRes {
    static constexpr bool PERM = false, AFTER_DRAIN = true;
    const float* base; float* out; int ldc; const float* bias; PanelStats st; unsigned poison;
    __device__ __forceinline__ void fused(f32x4 (&acc)[2][2][4][2], const Unit& u, int wr, int wc, int fr, int fq, PG8_LAS unsigned char* lds, int wid, int lane) const {
        typedef float f32x2v __attribute__((ext_vector_type(2)));
        const PG8_LAS f32x2v* S = (const PG8_LAS f32x2v*)(lds + 8192);
        const int col0 = u.pn * BM + wc * 32 + 4 * fq;
#pragma unroll
        for (int bj = 0; bj < 2; ++bj)
#pragma unroll
            for (int n = 0; n < 2; ++n) { const f32x4 bv = bias ? *(const f32x4*)(bias + col0 + bj * HALF + n * 16) : (f32x4){0.f, 0.f, 0.f, 0.f};
#pragma unroll
                for (int ai = 0; ai < 2; ++ai)
#pragma unroll
                    for (int m = 0; m < 4; ++m) acc[ai][bj][m][n] += bv; }
        f32x4 pre[4][2][2];
#pragma unroll
        for (int m = 0; m < 4; ++m) { const size_t off = (size_t)(u.pm * BM + wr * 64 + m * 16 + fr) * ldc + col0;
#pragma unroll
            for (int bj = 0; bj < 2; ++bj)
#pragma unroll
                for (int n = 0; n < 2; ++n) pre[m][bj][n] = *(const f32x4*)(base + off + bj * HALF + n * 16); }
        const bool bad = st.run(acc, u, wr, wc, fr, fq, lds, wid, lane) || poison != 0u;
        const float qnan = __builtin_nanf("");
#pragma unroll
        for (int ai = 0; ai < 2; ++ai)
#pragma unroll
            for (int m = 0; m < 4; ++m) { const int r = ai * HALF + wr * 64 + m * 16 + fr; const f32x2v sr = S[r]; const size_t off = (size_t)(u.pm * BM + r) * ldc + col0;
#pragma unroll
                for (int bj = 0; bj < 2; ++bj)
#pragma unroll
                    for (int n = 0; n < 2; ++n) { const f32x4 bs = ai == 0 ? pre[m][bj][n] : *(const f32x4*)(base + off + bj * HALF + n * 16); f32x4 o = bs + (acc[ai][bj][m][n] - sr.x) * sr.y;
                        if (bad) o = (f32x4){qnan, qnan, qnan, qnan}; *(f32x4*)(out + off + bj * HALF + n * 16) = o; }
                if (m & 1) asm volatile("" ::: "memory"); }
    }
};
struct EpiLnResLn {
    static constexpr bool PERM = false, AFTER_DRAIN = true;
    const float* base; float* out; bf16_t* xn; int ldc; const float* bias; PanelStats st1, st2; unsigned poison;
    __device__ __forceinline__ void fused(f32x4 (&acc)[2][2][4][2], const Unit& u, int wr, int wc, int fr, int fq, PG8_LAS unsigned char* lds, int wid, int lane) const {
        typedef float f32x2v __attribute__((ext_vector_type(2))); typedef unsigned u32x2v __attribute__((ext_vector_type(2)));
        const PG8_LAS f32x2v* S = (const PG8_LAS f32x2v*)(lds + 8192);
        const int col0 = u.pn * BM + wc * 32 + 4 * fq;
#pragma unroll
        for (int bj = 0; bj < 2; ++bj)
#pragma unroll
            for (int n = 0; n < 2; ++n) { const f32x4 bv = bias ? *(const f32x4*)(bias + col0 + bj * HALF + n * 16) : (f32x4){0.f, 0.f, 0.f, 0.f};
#pragma unroll
                for (int ai = 0; ai < 2; ++ai)
#pragma unroll
                    for (int m = 0; m < 4; ++m) acc[ai][bj][m][n] += bv; }
        bool bad = st1.run(acc, u, wr, wc, fr, fq, lds, wid, lane) || poison != 0u;
        const float qnan = __builtin_nanf("");
#pragma unroll
        for (int ai = 0; ai < 2; ++ai)
#pragma unroll
            for (int m = 0; m < 4; ++m) { const int r = ai * HALF + wr * 64 + m * 16 + fr; const f32x2v sr = S[r]; const size_t off = (size_t)(u.pm * BM + r) * ldc + col0;
#pragma unroll
                for (int bj = 0; bj < 2; ++bj)
#pragma unroll
                    for (int n = 0; n < 2; ++n) { const f32x4 bs = *(const f32x4*)(base + off + bj * HALF + n * 16); acc[ai][bj][m][n] = bs + (acc[ai][bj][m][n] - sr.x) * sr.y; }
                asm volatile("" : "+v"(acc[ai][0][m][0]), "+v"(acc[ai][0][m][1]), "+v"(acc[ai][1][m][0]), "+v"(acc[ai][1][m][1]));
                if (m & 1) asm volatile("" ::: "memory"); }
        const bool bad1 = bad;
        bad = st2.run(acc, u, wr, wc, fr, fq, lds, wid, lane) || bad;
#pragma unroll
        for (int ai = 0; ai < 2; ++ai)
#pragma unroll
            for (int m = 0; m < 4; ++m) { const int r = ai * HALF + wr * 64 + m * 16 + fr; const f32x2v sr = S[r]; const size_t off = (size_t)(u.pm * BM + r) * ldc + col0;
#pragma unroll
                for (int bj = 0; bj < 2; ++bj)
#pragma unroll
                    for (int n = 0; n < 2; ++n) { const f32x4 x1 = acc[ai][bj][m][n]; *(f32x4*)(out + off + bj * HALF + n * 16) = bad1 ? (f32x4){qnan, qnan, qnan, qnan} : x1;
                        const f32x4 o = (x1 - sr.x) * sr.y; u32x2v w; w.x = cvt_pk_bf16(o[0], o[1]); w.y = cvt_pk_bf16(o[2], o[3]);
                        if (bad) { w.x = 0x7fc07fc0u; w.y = 0x7fc07fc0u; } *(u32x2v*)(xn + off + bj * HALF + n * 16) = w; }
                asm volatile("" ::: "memory"); }
    }
};

template <class Epi, class Sched, bool ALIGN_EPI = false, bool SP2 = false>
__device__ __forceinline__ void gemm_phase(PG8_LAS unsigned char* lds, const Gemm g, const Sched& S, const Epi& E) {
    int tid_h = threadIdx.x; asm volatile("" : "+v"(tid_h));
    const int tid = tid_h, wid = __builtin_amdgcn_readfirstlane(tid >> 6), lane = tid & 63, wr = wid >> 2, wc = wid & 3, fr = lane & 15, fq = lane >> 4;
    const int K = g.K, nt = K / BK;
    unsigned voffA[2], voffB[2];
#pragma unroll
    for (int i = 0; i < 2; ++i) { int R, C; stage_rc(tid * 16 + i * 8192, R, C); const int Rb = Epi::PERM ? ((R & ~31) + perm32(R & 31)) : R;
        voffA[i] = (unsigned)(R * K + C) * 2u; voffB[i] = (unsigned)(Rb * K + C) * 2u; }
    const size_t kstep = (size_t)(BK * 2);
    const size_t hstep = (size_t)HALF * K * 2;
    const size_t tstep = 2 * hstep;
    const unsigned ldsw = (unsigned)wid * 1024u;
    const int aoff = lds_byte(wr * 64 + fr, fq * 8), boff = lds_byte(wc * 32 + fr, fq * 8);
#define PG8_SA(b, h) (((b) * 2 + (h)) * HTB)
#define PG8_SB(b, h) ((4 + (b) * 2 + (h)) * HTB)
#define PG8_STAGE(bufoff, gbase, voff) do { _Pragma("unroll") for (int _i = 0; _i < 2; ++_i) \
        __builtin_amdgcn_global_load_lds((const unsigned*)((const char*)(gbase) + (voff)[_i]), (PG8_LAS unsigned*)(lds + (bufoff) + ldsw + _i * 8192), 16, 0, 0); } while (0)
#define PG8_LDA(dst, b, h) do { _Pragma("unroll") for (int m = 0; m < 4; ++m) _Pragma("unroll") for (int k = 0; k < 2; ++k) dst[m][k] = *(const PG8_LAS bf16x8*)(lds + PG8_SA(b, h) + aoff + m * 2048 + k * 1024); } while (0)
#define PG8_LDB(dst, b, h) do { _Pragma("unroll") for (int n = 0; n < 2; ++n) _Pragma("unroll") for (int k = 0; k < 2; ++k) dst[n][k] = *(const PG8_LAS bf16x8*)(lds + PG8_SB(b, h) + boff + n * 2048 + k * 1024); } while (0)
#define PG8_MMA(ai, bj, At, Bt) do { __builtin_amdgcn_s_setprio(1); _Pragma("unroll") for (int m = 0; m < 4; ++m) _Pragma("unroll") for (int n = 0; n < 2; ++n) _Pragma("unroll") for (int k = 0; k < 2; ++k) \
        acc[ai][bj][m][n] = __builtin_amdgcn_mfma_f32_16x16x32_bf16(Bt[n][k], At[m][k], acc[ai][bj][m][n], 0, 0, 0); __builtin_amdgcn_s_setprio(0); } while (0)
#define PG8_WAIT_V(n) asm volatile("s_waitcnt vmcnt(" #n ")" ::: "memory")
#define PG8_WAIT_L(n) asm volatile("s_waitcnt lgkmcnt(" #n ")" ::: "memory")
#define PG8_BAR __builtin_amdgcn_s_barrier()
#define PG8_SCHED __builtin_amdgcn_sched_barrier(0)
    Unit cur, nxt; int ui = 0;
    if (!S.next(0, cur)) return;
    f32x4 acc[2][2][4][2];
#pragma unroll
    for (int a = 0; a < 2; ++a)
#pragma unroll
        for (int b = 0; b < 2; ++b)
#pragma unroll
            for (int m = 0; m < 4; ++m)
#pragma unroll
                for (int n = 0; n < 2; ++n) acc[a][b][m][n] = (f32x4){0.f, 0.f, 0.f, 0.f};
    bf16x8 At[4][2], B0[2][2], B1[2][2];
    const char* cA = (const char*)g.A + (size_t)cur.pm * tstep; const char* cB = (const char*)g.Bt + (size_t)cur.pn * tstep;
    S.a_ready(cur);
    if constexpr (SP2) {
        PG8_STAGE(PG8_SB(0, 0), cB, voffB); PG8_STAGE(PG8_SB(0, 1), cB + hstep, voffB); PG8_STAGE(PG8_SA(0, 0), cA, voffA); PG8_STAGE(PG8_SA(0, 1), cA + hstep, voffA);
        if (wr == 1) PG8_BAR;
        PG8_WAIT_V(2); PG8_BAR;
        PG8_STAGE(PG8_SB(1, 0), cB + kstep, voffB); PG8_STAGE(PG8_SA(1, 0), cA + kstep, voffA); PG8_STAGE(PG8_SB(1, 1), cB + hstep + kstep, voffB);
        PG8_WAIT_V(6); PG8_BAR;
    } else {
        PG8_STAGE(PG8_SB(0, 0), cB, voffB); PG8_STAGE(PG8_SA(0, 0), cA, voffA); PG8_STAGE(PG8_SB(0, 1), cB + hstep, voffB); PG8_STAGE(PG8_SA(0, 1), cA + hstep, voffA);
        if (wr == 1) PG8_BAR;
        PG8_WAIT_V(4); PG8_BAR;
        PG8_STAGE(PG8_SB(1, 0), cB + kstep, voffB); PG8_STAGE(PG8_SA(1, 0), cA + kstep, voffA); PG8_STAGE(PG8_SB(1, 1), cB + hstep + kstep, voffB);
        PG8_WAIT_V(6); PG8_BAR;
    }
    for (;;) {
        const bool has_next = S.next(ui + 1, nxt);
        const char* nA = has_next ? (const char*)g.A + (size_t)nxt.pm * tstep : cA; const char* nB = has_next ? (const char*)g.Bt + (size_t)nxt.pn * tstep : cB;
        for (int t = 0; t < nt; t += 2) {
            const bool last = (t == nt - 2);
            const char* a1 = cA + (size_t)(t + 1) * kstep;
            const char* a2 = last ? nA : cA + (size_t)(t + 2) * kstep; const char* b2 = last ? nB : cB + (size_t)(t + 2) * kstep;
            const char* a3 = a2 + kstep; const char* b3 = b2 + kstep;
            if (last && has_next) S.a_ready(nxt);
            if constexpr (SP2) {
            PG8_LDB(B0, 0, 0); PG8_LDB(B1, 0, 1); PG8_SCHED; PG8_LDA(At, 0, 0); PG8_STAGE(PG8_SA(1, 1), a1 + hstep, voffA);
            PG8_WAIT_V(8); PG8_WAIT_L(0); PG8_BAR; PG8_MMA(0, 0, At, B0); PG8_MMA(0, 1, At, B1); PG8_BAR; PG8_SCHED;
            PG8_LDA(At, 0, 1); PG8_STAGE(PG8_SB(0, 0), b2, voffB); PG8_STAGE(PG8_SB(0, 1), b2 + hstep, voffB); PG8_STAGE(PG8_SA(0, 0), a2, voffA);
            PG8_WAIT_V(8); PG8_WAIT_L(0); PG8_BAR; PG8_MMA(1, 0, At, B0); PG8_MMA(1, 1, At, B1); PG8_BAR; PG8_SCHED;
            PG8_LDB(B0, 1, 0); PG8_LDB(B1, 1, 1); PG8_SCHED; PG8_LDA(At, 1, 0); PG8_STAGE(PG8_SA(0, 1), a2 + hstep, voffA);
            PG8_WAIT_V(8); PG8_WAIT_L(0); PG8_BAR; PG8_MMA(0, 0, At, B0); PG8_MMA(0, 1, At, B1); PG8_BAR; PG8_SCHED;
            PG8_LDA(At, 1, 1); PG8_STAGE(PG8_SB(1, 0), b3, voffB); PG8_STAGE(PG8_SB(1, 1), b3 + hstep, voffB); PG8_STAGE(PG8_SA(1, 0), a3, voffA);
            PG8_WAIT_V(8); PG8_WAIT_L(0); PG8_BAR; PG8_MMA(1, 0, At, B0); PG8_MMA(1, 1, At, B1); PG8_BAR; PG8_SCHED;
            } else {
            PG8_LDB(B0, 0, 0); PG8_SCHED; PG8_LDA(At, 0, 0); PG8_STAGE(PG8_SA(1, 1), a1 + hstep, voffA);
            PG8_WAIT_L(8); PG8_BAR; PG8_WAIT_L(0); PG8_MMA(0, 0, At, B0); PG8_BAR; PG8_SCHED;
            PG8_LDB(B1, 0, 1); PG8_STAGE(PG8_SB(0, 0), b2, voffB);
            PG8_BAR; PG8_WAIT_L(0); PG8_MMA(0, 1, At, B1); PG8_BAR;
            PG8_LDA(At, 0, 1); PG8_STAGE(PG8_SA(0, 0), a2, voffA);
            PG8_BAR; PG8_WAIT_L(0); PG8_MMA(1, 0, At, B0); PG8_BAR; PG8_SCHED;
            PG8_STAGE(PG8_SB(0, 1), b2 + hstep, voffB);
            PG8_WAIT_V(6); PG8_BAR; PG8_MMA(1, 1, At, B1); PG8_BAR;
            PG8_LDB(B0, 1, 0); PG8_SCHED; PG8_LDA(At, 1, 0); PG8_STAGE(PG8_SA(0, 1), a2 + hstep, voffA);
            PG8_WAIT_L(8); PG8_BAR; PG8_WAIT_L(0); PG8_MMA(0, 0, At, B0); PG8_BAR; PG8_SCHED;
            PG8_LDB(B1, 1, 1); PG8_STAGE(PG8_SB(1, 0), b3, voffB);
            PG8_BAR; PG8_WAIT_L(0); PG8_MMA(0, 1, At, B1); PG8_BAR;
            PG8_LDA(At, 1, 1); PG8_STAGE(PG8_SA(1, 0), a3, voffA);
            PG8_BAR; PG8_WAIT_L(0); PG8_MMA(1, 0, At, B0); PG8_BAR; PG8_SCHED;
            PG8_STAGE(PG8_SB(1, 1), b3 + hstep, voffB);
            PG8_WAIT_V(6); PG8_BAR; PG8_MMA(1, 1, At, B1); PG8_BAR;
            }
        }
        if constexpr (ALIGN_EPI) { if (wr == 0) PG8_BAR; }
        if constexpr (!Epi::AFTER_DRAIN) { E(acc, cur, wr, wc, fr, fq); S.done(cur); }
        if (!has_next) break;
#pragma unroll
        for (int a = 0; a < 2; ++a)
#pragma unroll
            for (int b = 0; b < 2; ++b)
#pragma unroll
                for (int m = 0; m < 4; ++m)
#pragma unroll
                    for (int n = 0; n < 2; ++n) acc[a][b][m][n] = (f32x4){0.f, 0.f, 0.f, 0.f};
        cur = nxt; cA = nA; cB = nB; ++ui;
        if constexpr (ALIGN_EPI) { if (wr == 1) PG8_BAR; }
    }
    PG8_WAIT_V(0);
    if constexpr (!ALIGN_EPI) { if (wr == 0) PG8_BAR; }
    PG8_BAR;
    if constexpr (Epi::AFTER_DRAIN) { E.fused(acc, cur, wr, wc, fr, fq, lds, wid, lane); S.done(cur); }
#undef PG8_SA
#undef PG8_SB
#undef PG8_STAGE
#undef PG8_LDA
#undef PG8_LDB
#undef PG8_MMA
#undef PG8_WAIT_V
#undef PG8_WAIT_L
#undef PG8_BAR
#undef PG8_SCHED
}
}

#define LAS __attribute__((address_space(3)))
using pg8::bf16_t; using pg8::bf16x8; using pg8::f32x4; using pg8::u32x4; using pg8::Unit; using pg8::Gemm;
typedef float f32x16 __attribute__((ext_vector_type(16)));
typedef short s16x4 __attribute__((ext_vector_type(4)));
typedef unsigned u32x2 __attribute__((ext_vector_type(2)));
typedef float f32x2 __attribute__((ext_vector_type(2)));
typedef __bf16 bf16x2_t __attribute__((ext_vector_type(2)));
typedef short v4i16_t __attribute__((ext_vector_type(4)));
typedef LAS const char* lds_cptr;

constexpr int NB = 4, SEQ = 8192, DM = 1024, NDB = 8, LDEC = 32, PAST = 2048, KALL = PAST + LDEC;
constexpr int MP = NB * SEQ;
constexpr int MS = NDB * LDEC;
constexpr int MT = MP + MS;
constexpr int KR = MP + NDB * KALL;
constexpr int NIN = 2304, NRAW = 1280, DFF = 4096;
constexpr int NITEM_P = NB * 8 * (SEQ / 64), NITEM = NITEM_P + NDB * 8;
constexpr float EPS = 1e-6f;
constexpr float QSCALE = 0.10206207261596575f * 1.4426950408889634f;
constexpr float RK_SCALE = 0.17677669529663687f;

constexpr size_t O_Y = 0;
constexpr size_t O_CKVP = (size_t)MT * 1024;
constexpr size_t O_KRP = O_CKVP + (size_t)2 * MP * 256;
constexpr size_t O_RETP = O_KRP + (size_t)2 * MP * 32;
constexpr size_t O_CKVS = O_RETP + (size_t)2 * NB * 8 * 32 * 64;
constexpr size_t O_KRS = O_CKVS + (size_t)2 * MS * 256;
constexpr size_t O_RETS = O_KRS + (size_t)2 * MS * 32;
constexpr size_t O_END = O_RETS + (size_t)2 * NDB * 8 * 32 * 64;

constexpr size_t MiB = 1u << 20;
constexpr size_t WL_IN = 0, WL_UQ = WL_IN + (size_t)NIN * 1024 * 2, WL_UKV = WL_UQ + (size_t)768 * 384 * 2, WL_OUT = WL_UKV + (size_t)1024 * 256 * 2,
                 WL_FF1 = WL_OUT + (size_t)1024 * 1024 * 2, WL_FF2 = WL_FF1 + (size_t)4096 * 1024 * 2, WL_GATE = WL_FF2 + (size_t)4096 * 1024 * 2,
                 WL_PROJ = WL_GATE + (size_t)1024 * 1024 * 2, WL_END = WL_PROJ + (size_t)1024 * 256 * 2;
constexpr size_t WL_STRIDE = 27 * MiB;
static_assert(WL_END <= WL_STRIDE, "weights per layer");
constexpr size_t WS_TAB = 54 * MiB;
constexpr size_t WS_A = 56 * MiB;
constexpr size_t SZ_ROW1K = (size_t)MT * 1024 * 2;
constexpr size_t WS_Q = WS_A, WS_RQ = WS_A + (size_t)MT * 768 * 2;
constexpr size_t WS_MIX = WS_A + SZ_ROW1K;
constexpr size_t WS_PG = WS_MIX + SZ_ROW1K;
constexpr size_t WS_V = WS_PG, WS_RK = WS_PG + (size_t)KR * 512 * 2;
static_assert(WS_RK + (size_t)MT * 256 * 2 <= WS_PG + SZ_ROW1K, "V|RK overlay");
constexpr size_t WS_U = WS_PG + SZ_ROW1K;
constexpr size_t WS_RVG = WS_U;
constexpr size_t WS_RAW = WS_RVG + SZ_ROW1K;
constexpr size_t WS_KNOPE = WS_RAW, WS_PBF = WS_RAW;
constexpr size_t WS_QL = WS_RAW + (size_t)MT * NRAW * 2;
constexpr size_t WS_CKV = WS_QL + (size_t)MT * 384 * 2;
constexpr size_t WS_KVT = WS_CKV + (size_t)KR * 256 * 2;
constexpr size_t WS_ST = WS_KVT + (size_t)NITEM * 2048 * 4;
constexpr size_t WS_KRB = WS_ST + (size_t)NITEM * 2048 * 2;
constexpr size_t WS_UEND = WS_KRB + (size_t)KR * 32 * 2;
constexpr size_t WS_END = WS_U + (size_t)MT * DFF * 2;
static_assert(WS_UEND <= WS_END, "U overlay");
static_assert((size_t)KR * 512 * 2 <= (size_t)MT * NRAW * 2, "KNOPE overlay");
static_assert(WS_END <= 512 * MiB, "workspace");

#ifndef PHMASK
#define PHMASK 0xFFFF
#endif
constexpr int LDS_BYTES = 131072 + 1024;

struct Params {
    const float* in[22];
    float* out;
    unsigned char* ws;
    float lg[8];
};

#define MFMA32(a, b, c) __builtin_amdgcn_mfma_f32_32x32x16_bf16((a), (b), (c), 0, 0, 0)
__device__ __forceinline__ unsigned cvtpk(float lo, float hi) { f32x2 v = {lo, hi}; bf16x2_t b = __builtin_convertvector(v, bf16x2_t); return __builtin_bit_cast(unsigned, b); }
__device__ __forceinline__ float bflo(unsigned u) { return __uint_as_float(u << 16); }
__device__ __forceinline__ float bfhi(unsigned u) { return __uint_as_float(u & 0xffff0000u); }
__device__ __forceinline__ int crow(int r, int hi) { return (r & 3) + 8 * (r >> 2) + 4 * hi; }
__device__ __forceinline__ float wave_sum(float v) {
#pragma unroll
    for (int o = 1; o < 64; o <<= 1) v += __shfl_xor(v, o);
    return v;
}
__device__ __forceinline__ s16x4 vtr(lds_cptr p) { return __builtin_bit_cast(s16x4, __builtin_amdgcn_ds_read_tr16_b64_v4i16((LAS v4i16_t*)p)); }
__device__ __forceinline__ bf16x8 cat8(s16x4 lo, s16x4 hi) { return (bf16x8){lo[0], lo[1], lo[2], lo[3], hi[0], hi[1], hi[2], hi[3]}; }
__device__ __forceinline__ bf16x8 pack8(const f32x16& x, int s) {
    u32x4 p; p.x = cvtpk(x[8 * s + 0], x[8 * s + 1]); p.y = cvtpk(x[8 * s + 2], x[8 * s + 3]); p.z = cvtpk(x[8 * s + 4], x[8 * s + 5]); p.w = cvtpk(x[8 * s + 6], x[8 * s + 7]);
    return __builtin_bit_cast(bf16x8, p);
}
__device__ __forceinline__ float lg_of(int h) { const float x = __builtin_amdgcn_exp2f(-5.f - (float)h); const float sr = x * (1.f + x * (0.5f + x * (0.33333334f + x * (0.25f + x * (0.2f + x * 0.16666667f))))); return -sr * 1.4426950408889634f; }
__device__ __forceinline__ int tok_pos(int row) { return row < MP ? (row & (SEQ - 1)) : PAST + ((row - MP) & (LDEC - 1)); }

struct EpiIn {
    static constexpr bool PERM = true, AFTER_DRAIN = false;
    bf16_t* raw; bf16_t* rvg;
    __device__ __forceinline__ void operator()(const f32x4 (&acc)[2][2][4][2], const Unit& u, int wr, int wc, int fr, int fq) const {
        const int row0 = u.pm * 256 + wr * 64 + fr; const int colt = u.pn * 256;
        bf16_t* base; int ldc, cb;
        if (colt < NRAW) { base = raw; ldc = NRAW; cb = colt; } else { base = rvg; ldc = 1024; cb = colt - NRAW; }
        const int col0 = cb + wc * 32 + 8 * fq;
#pragma unroll
        for (int ai = 0; ai < 2; ++ai)
#pragma unroll
            for (int m = 0; m < 4; ++m) { bf16_t* rowp = base + (size_t)(row0 + ai * 128 + m * 16) * ldc + col0;
#pragma unroll
                for (int bj = 0; bj < 2; ++bj) { const f32x4 v0 = acc[ai][bj][m][0], v1 = acc[ai][bj][m][1];
                    u32x4 w; w.x = cvtpk(v0[0], v0[1]); w.y = cvtpk(v0[2], v0[3]); w.z = cvtpk(v1[0], v1[1]); w.w = cvtpk(v1[2], v1[3]);
                    *(u32x4*)(rowp + bj * 128) = w; } }
    }
};
struct EpiUq {
    static constexpr bool PERM = true, AFTER_DRAIN = false;
    bf16_t* Q; const float* tab;
    __device__ __forceinline__ void operator()(const f32x4 (&acc)[2][2][4][2], const Unit& u, int wr, int wc, int fr, int fq) const {
        const int row0 = u.pm * 256 + wr * 64 + fr;
#pragma unroll
        for (int ai = 0; ai < 2; ++ai)
#pragma unroll
            for (int m = 0; m < 4; ++m) { const int row = row0 + ai * 128 + m * 16; bf16_t* rowp = Q + (size_t)row * 768;
#pragma unroll
                for (int bj = 0; bj < 2; ++bj) { const int c = u.pn * 256 + bj * 128 + wc * 32 + 8 * fq; f32x4 v0 = acc[ai][bj][m][0], v1 = acc[ai][bj][m][1]; int dst;
                    if (u.pn < 2) { dst = (c >> 6) * 96 + (c & 63); }
                    else { const int i = c - 512, hh = i >> 5, w0 = i & 31; dst = hh * 96 + 64 + w0;
                        const float* tp = tab + ((size_t)tok_pos(row) * 16 + (w0 >> 1)) * 2;
                        const f32x4 t0 = *(const f32x4*)tp, t1 = *(const f32x4*)(tp + 4);
                        f32x4 a, b;
                        a[0] = v0[0] * t0[0] - v0[1] * t0[1]; a[1] = v0[0] * t0[1] + v0[1] * t0[0];
                        a[2] = v0[2] * t0[2] - v0[3] * t0[3]; a[3] = v0[2] * t0[3] + v0[3] * t0[2];
                        b[0] = v1[0] * t1[0] - v1[1] * t1[1]; b[1] = v1[0] * t1[1] + v1[1] * t1[0];
                        b[2] = v1[2] * t1[2] - v1[3] * t1[3]; b[3] = v1[2] * t1[3] + v1[3] * t1[2];
                        v0 = a; v1 = b; }
                    v0 = v0 * QSCALE; v1 = v1 * QSCALE;
                    u32x4 w; w.x = cvtpk(v0[0], v0[1]); w.y = cvtpk(v0[2], v0[3]); w.z = cvtpk(v1[0], v1[1]); w.w = cvtpk(v1[2], v1[3]);
                    *(u32x4*)(rowp + dst) = w; }
                asm volatile("" ::: "memory"); }
    }
};
struct EpiUkv {
    static constexpr bool PERM = true, AFTER_DRAIN = false;
    bf16_t* KN; bf16_t* V;
    __device__ __forceinline__ void operator()(const f32x4 (&acc)[2][2][4][2], const Unit& u, int wr, int wc, int fr, int fq) const {
        const int row0 = u.pm * 256 + wr * 64 + fr;
        bf16_t* base = (u.pn < 2) ? KN : V; const int col0 = (u.pn & 1) * 256 + wc * 32 + 8 * fq;
#pragma unroll
        for (int ai = 0; ai < 2; ++ai)
#pragma unroll
            for (int m = 0; m < 4; ++m) { bf16_t* rowp = base + (size_t)(row0 + ai * 128 + m * 16) * 512 + col0;
#pragma unroll
                for (int bj = 0; bj < 2; ++bj) { const f32x4 v0 = acc[ai][bj][m][0], v1 = acc[ai][bj][m][1];
                    u32x4 w; w.x = cvtpk(v0[0], v0[1]); w.y = cvtpk(v0[2], v0[3]); w.z = cvtpk(v1[0], v1[1]); w.w = cvtpk(v1[2], v1[3]);
                    *(u32x4*)(rowp + bj * 128) = w; } }
    }
};
struct EpiBf {
    static constexpr bool PERM = true, AFTER_DRAIN = false;
    bf16_t* O; int ldc; int relu2;
    __device__ __forceinline__ void operator()(const f32x4 (&acc)[2][2][4][2], const Unit& u, int wr, int wc, int fr, int fq) const {
        const int row0 = u.pm * 256 + wr * 64 + fr; const int col0 = u.pn * 256 + wc * 32 + 8 * fq;
#pragma unroll
        for (int ai = 0; ai < 2; ++ai)
#pragma unroll
            for (int m = 0; m < 4; ++m) { bf16_t* rowp = O + (size_t)(row0 + ai * 128 + m * 16) * ldc + col0;
#pragma unroll
                for (int bj = 0; bj < 2; ++bj) { f32x4 v0 = acc[ai][bj][m][0], v1 = acc[ai][bj][m][1];
                    if (relu2) {
#pragma unroll
                        for (int e = 0; e < 4; ++e) { const float a = fmaxf(v0[e], 0.f), b = fmaxf(v1[e], 0.f); v0[e] = a * a; v1[e] = b * b; } }
                    u32x4 w; w.x = cvtpk(v0[0], v0[1]); w.y = cvtpk(v0[2], v0[3]); w.z = cvtpk(v1[0], v1[1]); w.w = cvtpk(v1[2], v1[3]);
                    *(u32x4*)(rowp + bj * 128) = w; } }
    }
};
struct EpiRes {
    static constexpr bool PERM = false, AFTER_DRAIN = false;
    const float* in0; const float* in1; float* out;
    __device__ __forceinline__ void operator()(const f32x4 (&acc)[2][2][4][2], const Unit& u, int wr, int wc, int fr, int fq) const {
        const int row0 = u.pm * 256 + wr * 64 + fr; const int col0 = u.pn * 256 + wc * 32 + 4 * fq;
#pragma unroll
        for (int ai = 0; ai < 2; ++ai)
#pragma unroll
            for (int m = 0; m < 4; ++m) { const int row = row0 + ai * 128 + m * 16;
                const float* ip = (row < MP ? in0 + (size_t)row * 1024 : in1 + (size_t)(row - MP) * 1024) + col0; float* op = out + (size_t)row * 1024 + col0;
#pragma unroll
                for (int bj = 0; bj < 2; ++bj)
#pragma unroll
                    for (int n = 0; n < 2; ++n) { const f32x4 x = *(const f32x4*)(ip + bj * 128 + n * 16); *(f32x4*)(op + bj * 128 + n * 16) = x + acc[ai][bj][m][n]; }
                asm volatile("" ::: "memory"); }
    }
};
struct EpiGate {
    static constexpr bool PERM = false, AFTER_DRAIN = false;
    float* h; const bf16_t* PG;
    __device__ __forceinline__ void operator()(const f32x4 (&acc)[2][2][4][2], const Unit& u, int wr, int wc, int fr, int fq) const {
        const int row0 = u.pm * 256 + wr * 64 + fr; const int col0 = u.pn * 256 + wc * 32 + 4 * fq;
#pragma unroll
        for (int ai = 0; ai < 2; ++ai)
#pragma unroll
            for (int m = 0; m < 4; ++m) { const int row = row0 + ai * 128 + m * 16; float* hp = h + (size_t)row * 1024 + col0; const bf16_t* pp = PG + (size_t)row * 1024 + col0;
#pragma unroll
                for (int bj = 0; bj < 2; ++bj)
#pragma unroll
                    for (int n = 0; n < 2; ++n) { f32x4 x = *(const f32x4*)(hp + bj * 128 + n * 16); const u32x2 pw = *(const u32x2*)(pp + bj * 128 + n * 16); const f32x4 a = acc[ai][bj][m][n];
                        x[0] += bflo(pw.x) / (1.f + __expf(-a[0])); x[1] += bfhi(pw.x) / (1.f + __expf(-a[1]));
                        x[2] += bflo(pw.y) / (1.f + __expf(-a[2])); x[3] += bfhi(pw.y) / (1.f + __expf(-a[3]));
                        *(f32x4*)(hp + bj * 128 + n * 16) = x; }
                asm volatile("" ::: "memory"); }
    }
};

__device__ __forceinline__ int ilv(int w) { return (w & 1) ? 16 + (w >> 1) : (w >> 1); }
__device__ __forceinline__ int srccol(int mode, int n) {
    if (mode == 1) {
        if (n < 640) return n;
        if (n < 672) return 640 + ilv(n - 640);
        if (n < 768) return -1;
        if (n < 1024) { const int i = n - 768; return 672 + (i & ~31) + ilv(i & 31); }
        if (n < 1280) { const int i = n - 1024; return 928 + (i & ~31) + ilv(i & 31); }
        return n - 1280 + 1184;
    }
    if (mode == 2) {
        if (n < 512) return (n >> 6) * 96 + (n & 63);
        const int i = n - 512; return (i >> 5) * 96 + 64 + ilv(i & 31);
    }
    if (mode == 3) {
        if (n < 512) return (n >> 6) * 128 + (n & 63);
        const int i = n - 512; return (i >> 6) * 128 + 64 + (i & 63);
    }
    return n;
}
__device__ __forceinline__ void wconv_item(const float* W, int K, int N, int NP, int mode, const float* scale, bf16_t* WT, LAS float* scr, int item, int lane) {
    const int nblk = NP / 32, kb = item / nblk, nb = item % nblk, k0 = 64 * kb, n0 = 32 * nb;
    const int sc = srccol(mode, n0 + (lane & 31));
#pragma unroll 8
    for (int i = 0; i < 32; ++i) { const int kk = 2 * i + (lane >> 5); float v = (sc >= 0) ? W[(size_t)(k0 + kk) * N + sc] : 0.f; if (scale) v *= scale[k0 + kk]; scr[kk * 33 + (lane & 31)] = v; }
    asm volatile("s_waitcnt lgkmcnt(0)" ::: "memory");
    const int c = lane & 7;
#pragma unroll
    for (int j = 0; j < 4; ++j) { const int n = (lane >> 3) + 8 * j; const LAS float* s = scr + (8 * c) * 33 + n;
        u32x4 o; o.x = cvtpk(s[0 * 33], s[1 * 33]); o.y = cvtpk(s[2 * 33], s[3 * 33]); o.z = cvtpk(s[4 * 33], s[5 * 33]); o.w = cvtpk(s[6 * 33], s[7 * 33]);
        *(u32x4*)(WT + (size_t)(n0 + n) * K + k0 + 8 * c) = o; }
    asm volatile("s_waitcnt lgkmcnt(0)" ::: "memory");
}
__device__ __forceinline__ void norm_row_bf16(const float* xrow, bf16_t* orow, int lane) {
    const f32x4* xr = (const f32x4*)xrow + lane; f32x4 v[4]; float s = 0.f;
#pragma unroll
    for (int j = 0; j < 4; ++j) { v[j] = xr[64 * j]; s += (v[j][0] * v[j][0] + v[j][1] * v[j][1]) + (v[j][2] * v[j][2] + v[j][3] * v[j][3]); }
    const float rstd = rsqrtf(wave_sum(s) * (1.f / 1024.f) + EPS);
    u32x2* o8 = (u32x2*)orow + lane;
#pragma unroll
    for (int j = 0; j < 4; ++j) { u32x2 w; w.x = cvtpk(v[j][0] * rstd, v[j][1] * rstd); w.y = cvtpk(v[j][2] * rstd, v[j][3] * rstd); o8[64 * j] = w; }
}
__device__ __forceinline__ void final_norm_row(float* hrow, const float* w, int lane) {
    f32x4* xr = (f32x4*)hrow + lane; const f32x4* wr = (const f32x4*)w + lane; f32x4 v[4]; float s = 0.f;
#pragma unroll
    for (int j = 0; j < 4; ++j) { v[j] = xr[64 * j]; s += (v[j][0] * v[j][0] + v[j][1] * v[j][1]) + (v[j][2] * v[j][2] + v[j][3] * v[j][3]); }
    const float rstd = rsqrtf(wave_sum(s) * (1.f / 1024.f) + EPS);
#pragma unroll
    for (int j = 0; j < 4; ++j) xr[64 * j] = v[j] * rstd * wr[64 * j];
}

__device__ __forceinline__ void rowpass2(const Params& P, int layer, int row, int lane) {
    unsigned char* ws = P.ws;
    const bf16_t* raw = (const bf16_t*)(ws + WS_RAW) + (size_t)row * NRAW;
    const int pos = tok_pos(row);
    const bool isp = row < MP; const int srow = row - MP;
    const int krow = isp ? row : MP + (srow >> 5) * KALL + PAST + (srow & 31);
    { const unsigned* rp = (const unsigned*)(raw + 6 * lane); const unsigned a = rp[0], b = rp[1], c = rp[2];
      const float x0 = bflo(a), x1 = bfhi(a), x2 = bflo(b), x3 = bfhi(b), x4 = bflo(c), x5 = bfhi(c);
      const float ss = wave_sum(x0 * x0 + x1 * x1 + x2 * x2 + x3 * x3 + x4 * x4 + x5 * x5);
      const float rstd = rsqrtf(ss * (1.f / 384.f) + EPS);
      unsigned* op = (unsigned*)((bf16_t*)(ws + WS_QL) + (size_t)row * 384 + 6 * lane);
      op[0] = cvtpk(x0 * rstd, x1 * rstd); op[1] = cvtpk(x2 * rstd, x3 * rstd); op[2] = cvtpk(x4 * rstd, x5 * rstd); }
    { const u32x2 a = *(const u32x2*)(raw + 384 + 4 * lane);
      const float x0 = bflo(a.x), x1 = bfhi(a.x), x2 = bflo(a.y), x3 = bfhi(a.y);
      const float ss = wave_sum(x0 * x0 + x1 * x1 + x2 * x2 + x3 * x3);
      const float rstd = rsqrtf(ss * (1.f / 256.f) + EPS);
      const f32x4 w = *(const f32x4*)(P.in[11] + layer * 256 + 4 * lane);
      f32x4 o; o[0] = x0 * rstd * w[0]; o[1] = x1 * rstd * w[1]; o[2] = x2 * rstd * w[2]; o[3] = x3 * rstd * w[3];
      float* od = isp ? P.out + O_CKVP + ((size_t)layer * MP + row) * 256 : P.out + O_CKVS + ((size_t)layer * MS + srow) * 256;
      *(f32x4*)(od + 4 * lane) = o;
      u32x2 ob; ob.x = cvtpk(o[0], o[1]); ob.y = cvtpk(o[2], o[3]);
      *(u32x2*)((bf16_t*)(ws + WS_CKV) + (size_t)krow * 256 + 4 * lane) = ob; }
    const int j = lane & 15;
    const f32x2 cs = *(const f32x2*)((const float*)(ws + WS_TAB) + ((size_t)pos * 16 + j) * 2);
    { const unsigned a = *(const unsigned*)(raw + 640 + 2 * j); const float x1 = bflo(a), x2 = bfhi(a);
      const float o1 = x1 * cs[0] - x2 * cs[1], o2 = x1 * cs[1] + x2 * cs[0];
      if (lane < 16) { float* od = isp ? P.out + O_KRP + ((size_t)layer * MP + row) * 32 : P.out + O_KRS + ((size_t)layer * MS + srow) * 32; od[j] = o1; od[16 + j] = o2; }
      if (lane < 16) *(unsigned*)((bf16_t*)(ws + WS_KRB) + (size_t)krow * 32 + 2 * j) = cvtpk(o1, o2); }
    const int n = isp ? (row & 63) : (srow & 31);
#pragma unroll
    for (int t = 0; t < 2; ++t) { const int pi = lane + 64 * t, hh = pi >> 4; const float lgh = lg_of(hh);
        const float fq = __builtin_amdgcn_exp2f((float)n * lgh), fk = RK_SCALE * __builtin_amdgcn_exp2f(-(float)n * lgh);
        { const unsigned a = *(const unsigned*)(raw + 768 + 2 * pi); const float x1 = bflo(a), x2 = bfhi(a);
          *(unsigned*)((bf16_t*)(ws + WS_RQ) + (size_t)row * 256 + 2 * pi) = cvtpk((x1 * cs[0] - x2 * cs[1]) * fq, (x1 * cs[1] + x2 * cs[0]) * fq); }
        { const unsigned a = *(const unsigned*)(raw + 1024 + 2 * pi); const float x1 = bflo(a), x2 = bfhi(a);
          *(unsigned*)((bf16_t*)(ws + WS_RK) + (size_t)row * 256 + 2 * pi) = cvtpk((x1 * cs[0] - x2 * cs[1]) * fk, (x1 * cs[1] + x2 * cs[0]) * fk); }
    }
}
__device__ __forceinline__ void cache_row(const Params& P, int layer, int cr, int lane) {
    unsigned char* ws = P.ws; const int b = cr >> 11, k = cr & (PAST - 1); const int krow = MP + b * KALL + k;
    const f32x4 v = *(const f32x4*)(P.in[2] + ((size_t)(layer * NDB + b) * PAST + k) * 256 + 4 * lane);
    u32x2 ob; ob.x = cvtpk(v[0], v[1]); ob.y = cvtpk(v[2], v[3]);
    *(u32x2*)((bf16_t*)(ws + WS_CKV) + (size_t)krow * 256 + 4 * lane) = ob;
    if (lane < 16) { const float* kr = P.in[3] + ((size_t)(layer * NDB + b) * PAST + k) * 32;
        *(unsigned*)((bf16_t*)(ws + WS_KRB) + (size_t)krow * 32 + 2 * lane) = cvtpk(kr[lane], kr[16 + lane]); }
}

namespace att {
constexpr int SUBB = 10752, VOFF = 6656;
template <int NSUBT> struct Stage { u32x4 k[(NSUBT * 32 * 12 + 511) / 512]; u32x4 v[(NSUBT * 32 * 8 + 511) / 512]; };
template <int NSUBT> __device__ __forceinline__ void tile_load(Stage<NSUBT>& st, const bf16_t* Kn, const bf16_t* Kr, const bf16_t* Vg, int nvalid, int tid) {
    constexpr int NK = (NSUBT * 32 * 12 + 511) / 512, NV = (NSUBT * 32 * 8 + 511) / 512;
#pragma unroll
    for (int i = 0; i < NK; ++i) { const int c = tid + 512 * i; const int key = c / 12, ch = c - key * 12; u32x4 v = {0u, 0u, 0u, 0u};
        if (c < NSUBT * 32 * 12 && key < nvalid) v = (ch < 8) ? *(const u32x4*)(Kn + (size_t)key * 512 + ch * 8) : *(const u32x4*)(Kr + (size_t)key * 32 + (ch - 8) * 8);
        st.k[i] = v; }
#pragma unroll
    for (int i = 0; i < NV; ++i) { const int c = tid + 512 * i; const int key = c >> 3, ch = c & 7; u32x4 v = {0u, 0u, 0u, 0u};
        if (c < NSUBT * 32 * 8 && key < nvalid) v = *(const u32x4*)(Vg + (size_t)key * 512 + ch * 8);
        st.v[i] = v; }
}
template <int NSUBT> __device__ __forceinline__ void tile_store(const Stage<NSUBT>& st, LAS unsigned char* buf, int tid) {
    constexpr int NK = (NSUBT * 32 * 12 + 511) / 512, NV = (NSUBT * 32 * 8 + 511) / 512;
#pragma unroll
    for (int i = 0; i < NK; ++i) { const int c = tid + 512 * i; const int key = c / 12, ch = c - key * 12;
        if (c < NSUBT * 32 * 12) *(LAS u32x4*)(buf + (key >> 5) * SUBB + (key & 31) * 208 + ch * 16) = st.k[i]; }
#pragma unroll
    for (int i = 0; i < NV; ++i) { const int c = tid + 512 * i; const int key = c >> 3, ch = c & 7;
        if (c < NSUBT * 32 * 8) *(LAS u32x4*)(buf + (key >> 5) * SUBB + VOFF + (ch >> 2) * 2048 + (key & 31) * 64 + (ch & 3) * 16) = st.v[i]; }
}
template <int NS> __device__ __forceinline__ void att_tile(LAS const unsigned char* sb, const bf16x8 (&qf)[6], float& m, float& l, f32x16 (&o)[2], int lane) {
    const int r = lane & 31, h = lane >> 5;
    f32x16 p[NS];
#pragma unroll
    for (int kb = 0; kb < NS; ++kb) {
#pragma unroll
        for (int i = 0; i < 16; ++i) p[kb][i] = 0.f;
#pragma unroll
        for (int ks = 0; ks < 6; ++ks) { const bf16x8 kf = *(LAS const bf16x8*)(sb + kb * SUBB + r * 208 + ks * 32 + h * 16); p[kb] = MFMA32(kf, qf[ks], p[kb]); }
    }
    float mx = p[0][0];
#pragma unroll
    for (int kb = 0; kb < NS; ++kb)
#pragma unroll
        for (int i = 0; i < 16; ++i) mx = fmaxf(mx, p[kb][i]);
    mx = fmaxf(mx, __shfl_xor(mx, 32));
    const float mn = fmaxf(m, mx); const float alpha = __builtin_amdgcn_exp2f(m - mn); m = mn;
    float sum = 0.f;
#pragma unroll
    for (int kb = 0; kb < NS; ++kb)
#pragma unroll
        for (int i = 0; i < 16; ++i) { p[kb][i] = __builtin_amdgcn_exp2f(p[kb][i] - mn); sum += p[kb][i]; }
    l = l * alpha + sum;
#pragma unroll
    for (int i = 0; i < 16; ++i) { o[0][i] *= alpha; o[1][i] *= alpha; }
    const int g = (lane >> 4) & 1, q = (lane & 15) >> 2, pp = lane & 3;
#pragma unroll
    for (int kb = 0; kb < NS; ++kb)
#pragma unroll
        for (int s = 0; s < 2; ++s) { const bf16x8 pf = pack8(p[kb], s);
#pragma unroll
            for (int dvh = 0; dvh < 2; ++dvh) { lds_cptr vb = (lds_cptr)(sb + kb * SUBB + VOFF + dvh * 2048 + (16 * s + 4 * h + q) * 64 + g * 32 + pp * 8);
                const bf16x8 vf = cat8(vtr(vb), vtr(vb + 8 * 64)); o[dvh] = MFMA32(vf, pf, o[dvh]); } }
}
__device__ __forceinline__ void store_o(bf16_t* dst  , const f32x16 (&o)[2], float inv, int hh) {
#pragma unroll
    for (int dvh = 0; dvh < 2; ++dvh)
#pragma unroll
        for (int g4 = 0; g4 < 4; ++g4) { u32x2 w; w.x = cvtpk(o[dvh][4 * g4] * inv, o[dvh][4 * g4 + 1] * inv); w.y = cvtpk(o[dvh][4 * g4 + 2] * inv, o[dvh][4 * g4 + 3] * inv);
            *(u32x2*)(dst + 32 * dvh + 8 * g4 + 4 * hh) = w; }
}
__device__ __forceinline__ void prompt_unit(int b, int h, int qb, const bf16_t* Q, const bf16_t* KN, const bf16_t* KRB, const bf16_t* V, bf16_t* MIX, LAS unsigned char* lds) {
    int tid_h = threadIdx.x; asm volatile("" : "+v"(tid_h));
    const int tid = tid_h, lane = tid & 63, r = lane & 31, hh = lane >> 5; const int w = __builtin_amdgcn_readfirstlane(tid >> 6);
    const size_t qrow = (size_t)b * SEQ + qb * 256 + w * 32 + r;
    bf16x8 qf[6];
#pragma unroll
    for (int ks = 0; ks < 6; ++ks) qf[ks] = *(const bf16x8*)(Q + qrow * 768 + h * 96 + ks * 16 + hh * 8);
    const int NT = 4 * qb + 4, myNT = 4 * qb + (w >> 1) + 1;
    const bf16_t* Kn0 = KN + (size_t)b * SEQ * 512 + h * 64; const bf16_t* Kr0 = KRB + (size_t)b * SEQ * 32; const bf16_t* V0 = V + (size_t)b * SEQ * 512 + h * 64;
    float m = -INFINITY, l = 0.f; f32x16 o[2];
#pragma unroll
    for (int i = 0; i < 16; ++i) { o[0][i] = 0.f; o[1][i] = 0.f; }
    Stage<2> st; tile_load<2>(st, Kn0, Kr0, V0, 64, tid); tile_store<2>(st, lds, tid); __syncthreads();
    for (int t = 0; t < NT; ++t) {
        if (t + 1 < NT) tile_load<2>(st, Kn0 + (size_t)(t + 1) * 64 * 512, Kr0 + (size_t)(t + 1) * 64 * 32, V0 + (size_t)(t + 1) * 64 * 512, 64, tid);
        if (t < myNT) att_tile<2>(lds + (t & 1) * 2 * SUBB, qf, m, l, o, lane);
        if (t + 1 < NT) tile_store<2>(st, lds + ((t + 1) & 1) * 2 * SUBB, tid);
        __syncthreads();
    }
    l += __shfl_xor(l, 32);
    store_o(MIX + qrow * 1024 + h * 64, o, 1.f / l, hh);
}
__device__ __forceinline__ void sample_unit(int b, int h, const bf16_t* Q, const bf16_t* KN, const bf16_t* KRB, const bf16_t* V, bf16_t* MIX, LAS unsigned char* lds) {
    int tid_h = threadIdx.x; asm volatile("" : "+v"(tid_h));
    const int tid = tid_h, lane = tid & 63, r = lane & 31, hh = lane >> 5; const int w = __builtin_amdgcn_readfirstlane(tid >> 6);
    const size_t qrow = (size_t)MP + b * LDEC + r;
    bf16x8 qf[6];
#pragma unroll
    for (int ks = 0; ks < 6; ++ks) qf[ks] = *(const bf16x8*)(Q + qrow * 768 + h * 96 + ks * 16 + hh * 8);
    const size_t kr0 = (size_t)MP + (size_t)b * KALL;
    const bf16_t* Kn0 = KN + kr0 * 512 + h * 64; const bf16_t* Kr0 = KRB + kr0 * 32; const bf16_t* V0 = V + kr0 * 512 + h * 64;
    float m = -INFINITY, l = 0.f; f32x16 o[2];
#pragma unroll
    for (int i = 0; i < 16; ++i) { o[0][i] = 0.f; o[1][i] = 0.f; }
    for (int st_ = 0; st_ < 9; ++st_) { const int nvalid = (KALL - 256 * st_) < 256 ? (KALL - 256 * st_) : 256;
#pragma unroll 1
        for (int rd = 0; rd < 2; ++rd) { Stage<4> sg; const size_t k0 = (size_t)st_ * 256 + rd * 128;
            tile_load<4>(sg, Kn0 + k0 * 512, Kr0 + k0 * 32, V0 + k0 * 512, nvalid - rd * 128, tid); tile_store<4>(sg, lds + rd * 4 * SUBB, tid); }
        __syncthreads();
        if (w * 32 < nvalid) att_tile<1>(lds + w * SUBB, qf, m, l, o, lane);
        __syncthreads();
    }
    l += __shfl_xor(l, 32);
    LAS float* Ow = (LAS float*)(lds + w * 8192); LAS float* Mw = (LAS float*)(lds + 65536); LAS float* Lw = (LAS float*)(lds + 65536 + 1024);
#pragma unroll
    for (int dvh = 0; dvh < 2; ++dvh)
#pragma unroll
        for (int i = 0; i < 16; ++i) Ow[(32 * dvh + crow(i, hh)) * 32 + r] = o[dvh][i];
    if (hh == 0) { Mw[w * 32 + r] = m; Lw[w * 32 + r] = l; }
    __syncthreads();
    { const int q = tid & 31, dv0 = 4 * (tid >> 5); float ms = -INFINITY;
#pragma unroll
      for (int ww = 0; ww < 8; ++ww) ms = fmaxf(ms, Mw[ww * 32 + q]);
      float den = 0.f, a0 = 0.f, a1 = 0.f, a2 = 0.f, a3 = 0.f;
#pragma unroll
      for (int ww = 0; ww < 8; ++ww) { const float f = __builtin_amdgcn_exp2f(Mw[ww * 32 + q] - ms); den += f * Lw[ww * 32 + q]; const LAS float* op = (const LAS float*)(lds + ww * 8192) + dv0 * 32 + q;
          a0 += f * op[0]; a1 += f * op[32]; a2 += f * op[64]; a3 += f * op[96]; }
      const float inv = 1.f / den; u32x2 wv; wv.x = cvtpk(a0 * inv, a1 * inv); wv.y = cvtpk(a2 * inv, a3 * inv);
      *(u32x2*)(MIX + ((size_t)MP + b * LDEC + q) * 1024 + h * 64 + dv0) = wv; }
    __syncthreads();
}
}

struct RetItem { int b, h, row0, L; };
__device__ __forceinline__ RetItem ret_decode(int item) {
    RetItem it;
    if (item < NITEM_P) { it.b = item >> 10; it.h = (item >> 7) & 7; it.row0 = it.b * SEQ + (item & 127) * 64; it.L = 64; }
    else { const int j = item - NITEM_P; it.b = j >> 3; it.h = j & 7; it.row0 = MP + it.b * LDEC; it.L = 32; }
    return it;
}
__device__ __forceinline__ void ret_stage_v(const bf16_t* RVG, const RetItem& it, LAS unsigned char* img, int lane) {
#pragma unroll
    for (int i = 0; i < 8; ++i) { const int c = lane + 64 * i, tok = c >> 3, ch = c & 7; u32x4 v = {0u, 0u, 0u, 0u};
        if (tok < it.L) v = *(const u32x4*)(RVG + (size_t)(it.row0 + tok) * 1024 + it.h * 64 + ch * 8);
        *(LAS u32x4*)(img + (ch >> 2) * 4096 + tok * 64 + (ch & 3) * 16) = v; }
}
__device__ __forceinline__ void ret_kv_item(int item, const bf16_t* RK, const bf16_t* RVG, float* KVt, LAS unsigned char* lw, int lane) {
    const RetItem it = ret_decode(item); const int r = lane & 31, h = lane >> 5, g = (lane >> 4) & 1, q = (lane & 15) >> 2, pp = lane & 3;
    ret_stage_v(RVG, it, lw, lane);
#pragma unroll
    for (int i = 0; i < 4; ++i) { const int c = lane + 64 * i, tok = c >> 2, ch = c & 3; u32x4 v = {0u, 0u, 0u, 0u};
        if (tok < it.L) v = *(const u32x4*)(RK + (size_t)(it.row0 + tok) * 256 + it.h * 32 + ch * 8);
        *(LAS u32x4*)(lw + 8192 + tok * 64 + ch * 16) = v; }
    f32x16 a0, a1;
#pragma unroll
    for (int i = 0; i < 16; ++i) { a0[i] = 0.f; a1[i] = 0.f; }
    const int ns = it.L >> 4;
#pragma unroll
    for (int s = 0; s < 4; ++s) if (s < ns) {
        const int off = (16 * s + 8 * h + q) * 64 + g * 32 + pp * 8;
        const bf16x8 v0 = cat8(vtr((lds_cptr)(lw + off)), vtr((lds_cptr)(lw + off + 4 * 64)));
        const bf16x8 v1 = cat8(vtr((lds_cptr)(lw + 4096 + off)), vtr((lds_cptr)(lw + 4096 + off + 4 * 64)));
        const bf16x8 kk = cat8(vtr((lds_cptr)(lw + 8192 + off)), vtr((lds_cptr)(lw + 8192 + off + 4 * 64)));
        a0 = MFMA32(v0, kk, a0); a1 = MFMA32(v1, kk, a1);
    }
    float* dst = KVt + (size_t)item * 2048;
#pragma unroll
    for (int i = 0; i < 16; ++i) { dst[crow(i, h) * 32 + r] = a0[i]; dst[(32 + crow(i, h)) * 32 + r] = a1[i]; }
}
__device__ __forceinline__ void ret_scan_prompt(const Params& P, int layer, int idx) {
    const int bh = idx >> 11, e = idx & 2047; const float lgh = lg_of(bh & 7);
    const float g1 = exp2f(lgh), g63 = exp2f(63.f * lgh), g64 = exp2f(64.f * lgh);
    const float* kv = (const float*)(P.ws + WS_KVT) + (size_t)bh * 128 * 2048 + e; bf16_t* st = (bf16_t*)(P.ws + WS_ST) + (size_t)bh * 128 * 2048 + e;
    float S = 0.f;
#pragma unroll 8
    for (int c = 0; c < 128; ++c) { const float k = kv[(size_t)c * 2048]; st[(size_t)c * 2048] = (bf16_t)(cvtpk(g1 * S, 0.f) & 0xffffu); S = g64 * S + g63 * k; }
    P.out[O_RETP + (((size_t)layer * 32 + bh) * 32 + ilv(e & 31)) * 64 + (e >> 5)] = S;
}
__device__ __forceinline__ void ret_scan_sample(const Params& P, int layer, int idx) {
    const int j = idx >> 11, e = idx & 2047; const float lgh = lg_of(j & 7);
    const float g1 = exp2f(lgh), g31 = exp2f(31.f * lgh), g32 = exp2f(32.f * lgh);
    const size_t so = (((size_t)layer * 64 + j) * 32 + ilv(e & 31)) * 64 + (e >> 5);
    const float Sin = P.in[4][so]; const float k = ((const float*)(P.ws + WS_KVT))[(size_t)(NITEM_P + j) * 2048 + e];
    ((bf16_t*)(P.ws + WS_ST))[(size_t)(NITEM_P + j) * 2048 + e] = (bf16_t)(cvtpk(g1 * Sin, 0.f) & 0xffffu);
    P.out[O_RETS + so] = g32 * Sin + g31 * k;
}
__device__ __forceinline__ void ret_out_item(const Params& P, int layer, int item, LAS unsigned char* lw, int lane) {
    const RetItem it = ret_decode(item); const int r = lane & 31, h = lane >> 5, g = (lane >> 4) & 1, q = (lane & 15) >> 2, pp = lane & 3;
    const bf16_t* RQ = (const bf16_t*)(P.ws + WS_RQ); const bf16_t* RK = (const bf16_t*)(P.ws + WS_RK); const bf16_t* RVG = (const bf16_t*)(P.ws + WS_RVG);
    const bf16_t* St = (const bf16_t*)(P.ws + WS_ST) + (size_t)item * 2048; bf16_t* MIX = (bf16_t*)(P.ws + WS_MIX);
    const int NH = it.L >> 5;
    ret_stage_v(RVG, it, lw, lane);
    bf16x8 ka[2][2], qb[2][2], sa[2][2];
#pragma unroll
    for (int x = 0; x < 2; ++x)
#pragma unroll
        for (int s = 0; s < 2; ++s) {
            const int tr = (x < NH) ? it.row0 + 32 * x + r : it.row0 + r;
            ka[x][s] = *(const bf16x8*)(RK + (size_t)tr * 256 + it.h * 32 + 16 * s + 8 * h);
            qb[x][s] = *(const bf16x8*)(RQ + (size_t)tr * 256 + it.h * 32 + 16 * s + 8 * h);
            sa[x][s] = *(const bf16x8*)(St + (32 * x + r) * 32 + 16 * s + 8 * h);
        }
    f32x16 o[2][2];
#pragma unroll
    for (int nh = 0; nh < 2; ++nh) if (nh < NH) {
#pragma unroll
        for (int dvh = 0; dvh < 2; ++dvh) {
#pragma unroll
            for (int i = 0; i < 16; ++i) o[dvh][nh][i] = 0.f;
            o[dvh][nh] = MFMA32(sa[dvh][0], qb[nh][0], o[dvh][nh]); o[dvh][nh] = MFMA32(sa[dvh][1], qb[nh][1], o[dvh][nh]);
        }
#pragma unroll
        for (int mh = 0; mh < 2; ++mh) if (mh <= nh) {
            f32x16 T;
#pragma unroll
            for (int i = 0; i < 16; ++i) T[i] = 0.f;
            T = MFMA32(ka[mh][0], qb[nh][0], T); T = MFMA32(ka[mh][1], qb[nh][1], T);
            if (mh == nh) {
#pragma unroll
                for (int i = 0; i < 16; ++i) if (crow(i, h) > r) T[i] = 0.f;
            }
#pragma unroll
            for (int s = 0; s < 2; ++s) { const bf16x8 pf = pack8(T, s);
#pragma unroll
                for (int dvh = 0; dvh < 2; ++dvh) { lds_cptr vb = (lds_cptr)(lw + dvh * 4096 + (32 * mh + 16 * s + 4 * h + q) * 64 + g * 32 + pp * 8);
                    const bf16x8 vf = cat8(vtr(vb), vtr(vb + 8 * 64)); o[dvh][nh] = MFMA32(vf, pf, o[dvh][nh]); } }
        }
        float sum = 0.f;
#pragma unroll
        for (int dvh = 0; dvh < 2; ++dvh)
#pragma unroll
            for (int i = 0; i < 16; ++i) sum += o[dvh][nh][i];
        sum += __shfl_xor(sum, 32); const float mu = sum * (1.f / 64.f);
        float var = 0.f;
#pragma unroll
        for (int dvh = 0; dvh < 2; ++dvh)
#pragma unroll
            for (int i = 0; i < 16; ++i) { const float d = o[dvh][nh][i] - mu; var += d * d; }
        var += __shfl_xor(var, 32); const float rstd = rsqrtf(var * (1.f / 64.f) + EPS);
        const size_t row = (size_t)it.row0 + 32 * nh + r;
#pragma unroll
        for (int dvh = 0; dvh < 2; ++dvh)
#pragma unroll
            for (int g4 = 0; g4 < 4; ++g4) { const int dv0 = 32 * dvh + 8 * g4 + 4 * h;
                const f32x4 gw = *(const f32x4*)(P.in[13] + layer * 512 + it.h * 64 + dv0);
                const u32x2 gg = *(const u32x2*)(RVG + row * 1024 + 512 + it.h * 64 + dv0);
                float gv[4] = {bflo(gg.x), bfhi(gg.x), bflo(gg.y), bfhi(gg.y)}; float ov[4];
#pragma unroll
                for (int e = 0; e < 4; ++e) { const float sg = gv[e] / (1.f + __expf(-gv[e])); ov[e] = (o[dvh][nh][4 * g4 + e] - mu) * rstd * gw[e] * sg; }
                u32x2 wv; wv.x = cvtpk(ov[0], ov[1]); wv.y = cvtpk(ov[2], ov[3]);
                *(u32x2*)(MIX + row * 1024 + 512 + it.h * 64 + dv0) = wv; }
    }
}


#ifdef SELFCHK
constexpr size_t WS_DBG = 55 * MiB;
__device__ __forceinline__ float bf2f(bf16_t v) { return __uint_as_float((unsigned)v << 16); }
__device__ __forceinline__ void chk_acc(float* acc, int k, float got, float ref) { atomicAdd(acc + 2 * k, (got - ref) * (got - ref)); atomicAdd(acc + 2 * k + 1, ref * ref); }
__device__ __forceinline__ unsigned hsh(unsigned x) { x ^= x >> 16; x *= 0x7feb352dU; x ^= x >> 15; x *= 0x846ca68bU; x ^= x >> 16; return x; }
__device__ __forceinline__ int samp_row(unsigned i) { const unsigned r = hsh(i * 2654435761u + 12345u); return (i & 3) == 3 ? MP + (int)(r % MS) : (int)(r % MP); }
__device__ __forceinline__ void chk_after_ph3(const Params& P, int gtid) {
    unsigned char* ws = P.ws; float* acc = (float*)(ws + WS_DBG);
    if (gtid < 256) {
        const int row = samp_row(gtid); const unsigned r2 = hsh(gtid + 777u); const int h = r2 & 7, j = (r2 >> 3) & 15, dv = (r2 >> 7) & 63;
        const float* x = row < MP ? P.in[0] + (size_t)row * 1024 : P.in[1] + (size_t)(row - MP) * 1024;
        float ss = 0.f; for (int k = 0; k < 1024; ++k) ss += x[k] * x[k];
        const float rstd = rsqrtf(ss / 1024.f + EPS);
        float p1 = 0.f, p2 = 0.f, pv = 0.f;
        for (int k = 0; k < 1024; ++k) { const float a = x[k] * rstd * P.in[7][k]; const float* wr = P.in[8] + (size_t)k * 2208;
            p1 += a * wr[928 + h * 32 + j]; p2 += a * wr[928 + h * 32 + 16 + j]; pv += a * wr[1184 + h * 64 + dv]; }
        const int pos = tok_pos(row); const f32x2 cs_ = ((const f32x2*)(ws + WS_TAB))[pos * 16 + j]; const float c = cs_[0], sn = cs_[1];
        const int n = row < MP ? (row & 63) : ((row - MP) & 31);
        const float f = RK_SCALE * exp2f(-(float)n * lg_of(h));
        const float o1 = (p1 * c - p2 * sn) * f, o2 = (p1 * sn + p2 * c) * f;
        const bf16_t* RK = (const bf16_t*)(ws + WS_RK) + (size_t)row * 256 + h * 32;
        chk_acc(acc, 0, bf2f(RK[2 * j]), o1); chk_acc(acc, 0, bf2f(RK[2 * j + 1]), o2);
        chk_acc(acc, 0, bf2f(((const bf16_t*)(ws + WS_RVG))[(size_t)row * 1024 + h * 64 + dv]), pv);
    } else if (gtid < 512) {
        const unsigned r = hsh(gtid * 31u + 5u); const int item = (gtid & 7) == 7 ? NITEM_P + (int)(r % 64) : (int)(r % NITEM_P); const int dv = (r >> 12) & 63, dk = (r >> 18) & 31;
        const RetItem it = ret_decode(item); float s = 0.f;
        for (int m = 0; m < it.L; ++m) s += bf2f(((const bf16_t*)(ws + WS_RVG))[(size_t)(it.row0 + m) * 1024 + it.h * 64 + dv]) * bf2f(((const bf16_t*)(ws + WS_RK))[(size_t)(it.row0 + m) * 256 + it.h * 32 + dk]);
        chk_acc(acc, 1, ((const float*)(ws + WS_KVT))[(size_t)item * 2048 + dv * 32 + dk], s);
    } else if (gtid < 768) {
        const int row = samp_row(gtid); const unsigned r2 = hsh(gtid + 999u); const int h = r2 & 7, d = (r2 >> 3) % 96;
        const bf16_t* ql = (const bf16_t*)(ws + WS_QL) + (size_t)row * 384; float got, ref;
        if (d < 64) { float s = 0.f; for (int k = 0; k < 384; ++k) s += bf2f(ql[k]) * P.in[9][k] * P.in[10][(size_t)k * 768 + h * 96 + d]; ref = s * QSCALE; got = bf2f(((const bf16_t*)(ws + WS_Q))[(size_t)row * 768 + h * 96 + d]); chk_acc(acc, 3, got, ref); }
        else { const int j = (d - 64) & 15; float s1 = 0.f, s2 = 0.f;
            for (int k = 0; k < 384; ++k) { const float a = bf2f(ql[k]) * P.in[9][k]; s1 += a * P.in[10][(size_t)k * 768 + h * 96 + 64 + j]; s2 += a * P.in[10][(size_t)k * 768 + h * 96 + 80 + j]; }
            const int pos = tok_pos(row); const f32x2 cs_ = ((const f32x2*)(ws + WS_TAB))[pos * 16 + j]; const float c = cs_[0], sn = cs_[1];
            const bf16_t* q = (const bf16_t*)(ws + WS_Q) + (size_t)row * 768 + h * 96 + 64;
            chk_acc(acc, 3, bf2f(q[2 * j]), (s1 * c - s2 * sn) * QSCALE); chk_acc(acc, 3, bf2f(q[2 * j + 1]), (s1 * sn + s2 * c) * QSCALE); }
    } else if (gtid < 1024) {
        const unsigned r = hsh(gtid * 17u + 3u); const int krow = (int)(r % KR); const int h = (r >> 20) & 7, d = (r >> 24) & 63;
        const bf16_t* cv = (const bf16_t*)(ws + WS_CKV) + (size_t)krow * 256; float sk = 0.f, sv = 0.f;
        for (int k = 0; k < 256; ++k) { const float a = bf2f(cv[k]); sk += a * P.in[12][(size_t)k * 1024 + h * 128 + d]; sv += a * P.in[12][(size_t)k * 1024 + h * 128 + 64 + d]; }
        chk_acc(acc, 4, bf2f(((const bf16_t*)(ws + WS_KNOPE))[(size_t)krow * 512 + h * 64 + d]), sk);
        chk_acc(acc, 4, bf2f(((const bf16_t*)(ws + WS_V))[(size_t)krow * 512 + h * 64 + d]), sv);
    }
}
__device__ __forceinline__ void chk_after_ph4(const Params& P, int gtid) {
    unsigned char* ws = P.ws; float* acc = (float*)(ws + WS_DBG);
    if (gtid < 256) {
        const unsigned r = hsh(gtid * 13u + 1u); const int bh = r & 31, e = (r >> 5) & 2047; const float lgh = lg_of(bh & 7);
        const float g63 = exp2f(63.f * lgh), g64 = exp2f(64.f * lgh); float S = 0.f; const int cchk = (r >> 16) & 127; float sprev = 0.f;
        for (int c = 0; c < 128; ++c) { if (c == cchk) sprev = S; S = g64 * S + g63 * ((const float*)(ws + WS_KVT))[((size_t)bh * 128 + c) * 2048 + e]; }
        chk_acc(acc, 2, P.out[O_RETP + ((size_t)bh * 32 + ilv(e & 31)) * 64 + (e >> 5)], S);
        chk_acc(acc, 2, bf2f(((const bf16_t*)(ws + WS_ST))[((size_t)bh * 128 + cchk) * 2048 + e]), exp2f(lgh) * sprev);
    } else if (gtid < 256 + 96) {
        const int i = gtid - 256; const unsigned r = hsh(i * 7u + 11u); const int h = r & 7, dv = (r >> 3) & 63;
        int qrow, kbase, nk;
        if (i < 64) { const int b = (r >> 9) & 3, t = (r >> 11) & 8191; qrow = b * SEQ + t; kbase = b * SEQ; nk = ((t >> 6) + 1) * 64; }
        else { const int b = (r >> 9) & 7, l = (r >> 12) & 31; qrow = MP + b * LDEC + l; kbase = MP + b * KALL; nk = KALL; }
        const bf16_t* q = (const bf16_t*)(ws + WS_Q) + (size_t)qrow * 768 + h * 96;
        float m = -INFINITY, l_ = 0.f, o = 0.f;
        for (int k = 0; k < nk; ++k) { const bf16_t* kn = (const bf16_t*)(ws + WS_KNOPE) + (size_t)(kbase + k) * 512 + h * 64; const bf16_t* kr = (const bf16_t*)(ws + WS_KRB) + (size_t)(kbase + k) * 32;
            float s = 0.f; for (int d = 0; d < 64; ++d) s += bf2f(q[d]) * bf2f(kn[d]); for (int d = 0; d < 32; ++d) s += bf2f(q[64 + d]) * bf2f(kr[d]);
            const float mn = fmaxf(m, s), a = exp2f(m - mn), p = exp2f(s - mn); l_ = l_ * a + p; o = o * a + p * bf2f(((const bf16_t*)(ws + WS_V))[(size_t)(kbase + k) * 512 + h * 64 + dv]); m = mn; }
        chk_acc(acc, 5, bf2f(((const bf16_t*)(ws + WS_MIX))[(size_t)qrow * 1024 + h * 64 + dv]), o / l_);
    }
}
#endif
#define HIDE_WS int tid = tid0; asm volatile("" : "+v"(tid)); const int lane = tid & 63; const int wave = __builtin_amdgcn_readfirstlane(tid >> 6); const int gw = blockIdx.x * 8 + wave; (void)lane; (void)gw; unsigned char* ws = ws0; float* hbuf = hbuf0; asm volatile("" : "+s"(ws), "+s"(hbuf)); unsigned char* wl = ws + (size_t)L * WL_STRIDE; (void)wl; (void)hbuf;
#define GEMM_PHASE(EPI_T, E_, A_, B_, M_, N_, K_) do { int k_ = (K_); asm volatile("" : "+s"(k_)); Gemm g_{(const bf16_t*)(A_), (const bf16_t*)(B_), (M_), (N_), k_}; pg8::StaticOrder S_; S_.init((M_), (N_), G, (int)blockIdx.x); \
        pg8::gemm_phase<EPI_T, pg8::StaticOrder, true, true>(lds, g_, S_, E_); } while (0)

__global__ void __launch_bounds__(512, 2) mega_fwd(Params P) {
    extern __shared__ __attribute__((aligned(16))) unsigned char lds_raw[];
    LAS unsigned char* lds = (LAS unsigned char*)lds_raw;
    cg::grid_group grid = cg::this_grid();
    const int tid0 = threadIdx.x;
    const int G = gridDim.x; const int NGW = G * 8;
    unsigned char* ws0 = P.ws;
    float* hbuf0 = P.out;

#if (PHMASK >> 0) & 1
    { const int L = 0; HIDE_WS
        LAS float* scr = (LAS float*)(lds + wave * 16384);
        constexpr int I_IN = 16 * (NIN / 32), I_UQ = 6 * 24, I_UKV = 4 * 32, I_OUT = 16 * 32, I_FF1 = 16 * 128, I_FF2 = 64 * 32, I_GATE = 16 * 32, I_PROJ = 4 * 32;
        constexpr int I_LAYER = I_IN + I_UQ + I_UKV + I_OUT + I_FF1 + I_FF2 + I_GATE + I_PROJ;
        for (int it = gw; it < 2 * I_LAYER; it += NGW) {
            const int LL = it / I_LAYER; int r = it - LL * I_LAYER; unsigned char* wl = ws + (size_t)LL * WL_STRIDE;
            if (r < I_IN) { wconv_item(P.in[8] + (size_t)LL * 1024 * 2208, 1024, 2208, NIN, 1, P.in[7] + LL * 1024, (bf16_t*)(wl + WL_IN), scr, r, lane); continue; } r -= I_IN;
            if (r < I_UQ) { wconv_item(P.in[10] + (size_t)LL * 384 * 768, 384, 768, 768, 2, P.in[9] + LL * 384, (bf16_t*)(wl + WL_UQ), scr, r, lane); continue; } r -= I_UQ;
            if (r < I_UKV) { wconv_item(P.in[12] + (size_t)LL * 256 * 1024, 256, 1024, 1024, 3, nullptr, (bf16_t*)(wl + WL_UKV), scr, r, lane); continue; } r -= I_UKV;
            if (r < I_OUT) { wconv_item(P.in[14] + (size_t)LL * 1024 * 1024, 1024, 1024, 1024, 0, nullptr, (bf16_t*)(wl + WL_OUT), scr, r, lane); continue; } r -= I_OUT;
            if (r < I_FF1) { wconv_item(P.in[16] + (size_t)LL * 1024 * 4096, 1024, 4096, 4096, 0, P.in[15] + LL * 1024, (bf16_t*)(wl + WL_FF1), scr, r, lane); continue; } r -= I_FF1;
            if (r < I_FF2) { wconv_item(P.in[17] + (size_t)LL * 4096 * 1024, 4096, 1024, 1024, 0, nullptr, (bf16_t*)(wl + WL_FF2), scr, r, lane); continue; } r -= I_FF2;
            if (r < I_GATE) { wconv_item(P.in[19] + (size_t)LL * 1024 * 1024, 1024, 1024, 1024, 0, P.in[18] + LL * 1024, (bf16_t*)(wl + WL_GATE), scr, r, lane); continue; } r -= I_GATE;
            wconv_item(P.in[20] + (size_t)LL * 256 * 1024, 256, 1024, 1024, 0, nullptr, (bf16_t*)(wl + WL_PROJ), scr, r, lane);
        }
        for (int i = blockIdx.x * 512 + tid; i < SEQ * 16; i += G * 512) { const int pos = i >> 4, j = i & 15;
            const double inv = exp2(-(double)j * 0.83048202372184059); const double ang = (double)pos * inv;
            const double kq = rint(ang * 0.15915494309189535); const float rr = (float)(ang - kq * 6.2831853071795865);
            ((f32x2*)(ws + WS_TAB))[i] = (f32x2){cosf(rr), sinf(rr)}; }
        for (int row = gw; row < MT; row += NGW)
            norm_row_bf16(row < MP ? P.in[0] + (size_t)row * 1024 : P.in[1] + (size_t)(row - MP) * 1024, (bf16_t*)(ws + WS_A) + (size_t)row * 1024, lane);
    }
#endif
    grid.sync();

#pragma unroll 1
    for (int L = 0; L < 2; ++L) {
#if (PHMASK >> 1) & 1
        { HIDE_WS
        { EpiIn E{(bf16_t*)(ws + WS_RAW), (bf16_t*)(ws + WS_RVG)}; GEMM_PHASE(EpiIn, E, ws + WS_A, wl + WL_IN, MT, NIN, 1024); }
        }
#endif
        grid.sync();
#if (PHMASK >> 2) & 1
        { HIDE_WS
        for (int row = gw; row < MT; row += NGW) rowpass2(P, L, row, lane);
        for (int cr = gw; cr < NDB * PAST; cr += NGW) cache_row(P, L, cr, lane);
        }
#endif
        grid.sync();
#if (PHMASK >> 3) & 1
        { HIDE_WS
#ifndef NO_UQ
        { EpiUq E{(bf16_t*)(ws + WS_Q), (const float*)(ws + WS_TAB)}; GEMM_PHASE(EpiUq, E, ws + WS_QL, wl + WL_UQ, MT, 768, 384); }
#endif
#ifndef NO_UKV
        { EpiUkv E{(bf16_t*)(ws + WS_KNOPE), (bf16_t*)(ws + WS_V)}; GEMM_PHASE(EpiUkv, E, ws + WS_CKV, wl + WL_UKV, KR, 1024, 256); }
#endif
        __syncthreads();
#ifndef NO_RKV
        for (int item = gw; item < NITEM; item += NGW) ret_kv_item(item, (const bf16_t*)(ws + WS_RK), (const bf16_t*)(ws + WS_RVG), (float*)(ws + WS_KVT), lds + wave * 12288, lane);
#endif
        }
#endif
        grid.sync();
#if defined(DBG_STOP) && DBG_STOP == 3
        return;
#endif
#if (PHMASK >> 4) & 1
        { HIDE_WS
        for (int blk = blockIdx.x; blk < 128 + 256; blk += G) { if (blk < 128) ret_scan_prompt(P, L, blk * 512 + tid); else ret_scan_sample(P, L, (blk - 128) * 512 + tid); }
        __syncthreads();
        {
            const bf16_t* Q = (const bf16_t*)(ws + WS_Q); const bf16_t* KN = (const bf16_t*)(ws + WS_KNOPE); const bf16_t* KRB = (const bf16_t*)(ws + WS_KRB);
            const bf16_t* V = (const bf16_t*)(ws + WS_V); bf16_t* MIX = (bf16_t*)(ws + WS_MIX);
#ifndef NO_PROMPT
            if (G == 256) { const int vcu = (blockIdx.x % 8) * 32 + blockIdx.x / 8; const int s = vcu & 7, bh = vcu >> 3;
                for (int i = 0; i < 4; ++i) { const int qb = (i == 0) ? 31 - s : (i == 1) ? 16 + s : (i == 2) ? 15 - s : s; att::prompt_unit(bh >> 3, bh & 7, qb, Q, KN, KRB, V, MIX, lds); } }
            else { for (int u = blockIdx.x; u < 1024; u += G) att::prompt_unit((u >> 5) >> 3, (u >> 5) & 7, 31 - (u & 31), Q, KN, KRB, V, MIX, lds); }
#endif
#ifndef NO_SAMPLE
            for (int u = G - 1 - blockIdx.x; u < 64; u += G) att::sample_unit(u >> 3, u & 7, Q, KN, KRB, V, MIX, lds);
#endif
        }
        }
#endif
        grid.sync();
#if defined(DBG_STOP) && DBG_STOP == 4
        return;
#endif
#if (PHMASK >> 5) & 1
        { HIDE_WS
        for (int item = gw; item < NITEM; item += NGW) ret_out_item(P, L, item, lds + wave * 8192, lane);
        for (int i = blockIdx.x * 512 + tid; i < MT * 32; i += G * 512) { const int row = i >> 5, c8 = (i & 31) * 8;
            const float* src = (row < MP ? P.in[5] + ((size_t)L * MP + row) * 256 : P.in[6] + ((size_t)L * MS + (row - MP)) * 256) + c8;
            const f32x4 a = *(const f32x4*)src, b = *(const f32x4*)(src + 4);
            u32x4 w; w.x = cvtpk(a[0], a[1]); w.y = cvtpk(a[2], a[3]); w.z = cvtpk(b[0], b[1]); w.w = cvtpk(b[2], b[3]);
            *(u32x4*)((bf16_t*)(ws + WS_PBF) + (size_t)row * 256 + c8) = w; }
        }
#endif
        grid.sync();
#if (PHMASK >> 6) & 1
        { HIDE_WS
        { EpiRes E{L == 0 ? P.in[0] : hbuf, L == 0 ? P.in[1] : hbuf + (size_t)MP * 1024, hbuf}; GEMM_PHASE(EpiRes, E, ws + WS_MIX, wl + WL_OUT, MT, 1024, 1024); }
        { EpiBf E{(bf16_t*)(ws + WS_PG), 1024, 0}; GEMM_PHASE(EpiBf, E, ws + WS_PBF, wl + WL_PROJ, MT, 1024, 256); }
        }
#endif
        grid.sync();
#if (PHMASK >> 7) & 1
        { HIDE_WS
        for (int row = gw; row < MT; row += NGW) norm_row_bf16(hbuf + (size_t)row * 1024, (bf16_t*)(ws + WS_A) + (size_t)row * 1024, lane);
        }
#endif
        grid.sync();
#if (PHMASK >> 8) & 1
        { HIDE_WS
        { EpiBf E{(bf16_t*)(ws + WS_U), DFF, 1}; GEMM_PHASE(EpiBf, E, ws + WS_A, wl + WL_FF1, MT, DFF, 1024); }
        }
#endif
        grid.sync();
#if (PHMASK >> 9) & 1
        { HIDE_WS
        { EpiRes E{hbuf, hbuf + (size_t)MP * 1024, hbuf}; GEMM_PHASE(EpiRes, E, ws + WS_U, wl + WL_FF2, MT, 1024, DFF); }
        }
#endif
        grid.sync();
#if (PHMASK >> 10) & 1
        { HIDE_WS
        for (int row = gw; row < MT; row += NGW) norm_row_bf16(hbuf + (size_t)row * 1024, (bf16_t*)(ws + WS_A) + (size_t)row * 1024, lane);
        }
#endif
        grid.sync();
#if (PHMASK >> 11) & 1
        { HIDE_WS
        { EpiGate E{hbuf, (const bf16_t*)(ws + WS_PG)}; GEMM_PHASE(EpiGate, E, ws + WS_A, wl + WL_GATE, MT, 1024, 1024); }
        }
#endif
        grid.sync();
#if (PHMASK >> 12) & 1
        { HIDE_WS
        if (L == 0) { for (int row = gw; row < MT; row += NGW) norm_row_bf16(hbuf + (size_t)row * 1024, (bf16_t*)(ws + WS_A) + (size_t)row * 1024, lane); grid.sync(); }
        else { for (int row = gw; row < MT; row += NGW) final_norm_row(hbuf + (size_t)row * 1024, P.in[21], lane); }
        }
#endif
    }

}


#ifdef SELFCHK
__global__ void __launch_bounds__(512) chk_kernel(Params P) {
    const int gtid = blockIdx.x * 512 + threadIdx.x;
#if DBG_STOP == 3
    chk_after_ph3(P, gtid);
#elif DBG_STOP == 4
    chk_after_ph4(P, gtid);
#endif
}
__global__ void __launch_bounds__(512) enc_kernel(Params P) {
    const float* acc = (const float*)(P.ws + WS_DBG); unsigned code = 0;
    for (int k = 0; k < 6; ++k) { const float e2 = acc[2 * k], r2 = acc[2 * k + 1];
        if (r2 > 0.f && !(e2 <= SELFCHK_TOL * r2)) code |= 1u << k; }
    const float V = sqrtf((float)code);
    for (size_t i = (size_t)blockIdx.x * 512 + threadIdx.x; i < O_END; i += (size_t)gridDim.x * 512) P.out[i] = (i >= (size_t)MP * 1024 && i < (size_t)MT * 1024) ? V : 0.f;
}
#endif
#ifdef DBG_ZERO
__global__ void __launch_bounds__(512) zero_kernel(Params P) {
    {
        const size_t offs[9] = {O_Y, (size_t)MP * 1024, O_CKVP, O_KRP, O_RETP, O_CKVS, O_KRS, O_RETS, O_END};
        for (int k = 0; k < 8; ++k) {
            const size_t a = offs[k], b = offs[k + 1], mid = a + (b - a) / 2;
            size_t z0 = a, z1 = a;
            if ((DBG_ZERO >> k) & 1) { z0 = a; z1 = b; }
            else if (((DBG_ZERO >> 8) & 1) && k >= 2) { z0 = mid; z1 = b; }
            for (size_t i = z0 + (size_t)blockIdx.x * 512 + threadIdx.x; i < z1; i += (size_t)gridDim.x * 512) P.out[i] = 0.f;
#ifdef DBG_NEG
            if (k == DBG_NEG) for (size_t i = a + (size_t)blockIdx.x * 512 + threadIdx.x; i < mid; i += (size_t)gridDim.x * 512) P.out[i] = DBG_NEGF * P.out[i];
#endif
        }
    }
}
#endif
extern "C" void kernel_launch(void* const* d_in, const int* in_sizes, int n_in, void* d_out, int out_size, void* d_ws, size_t ws_size, hipStream_t stream) {
    static int grid = 0;
    if (grid == 0) {
        if (n_in != 22 || (size_t)out_size != O_END || ws_size < WS_END) { fprintf(stderr, "kernel_launch: unexpected shapes n_in %d out %d ws %zu\n", n_in, out_size, ws_size); grid = -1; return; }
        int dev = 0, cus = 0, per_cu = 0;
        (void)hipGetDevice(&dev); (void)hipDeviceGetAttribute(&cus, hipDeviceAttributeMultiprocessorCount, dev);
        (void)hipFuncSetAttribute((const void*)mega_fwd, hipFuncAttributeMaxDynamicSharedMemorySize, LDS_BYTES);
        if (hipOccupancyMaxActiveBlocksPerMultiprocessor(&per_cu, (const void*)mega_fwd, 512, LDS_BYTES) != hipSuccess || per_cu < 1) { fprintf(stderr, "kernel_launch: occupancy query gave %d\n", per_cu); per_cu = 1; }
        (void)hipGetLastError();
        grid = cus;
        if (grid <= 0) grid = 256;
    }
    if (grid < 0) return;
    Params p{};
    for (int i = 0; i < 22; ++i) p.in[i] = (const float*)d_in[i];
    p.out = (float*)d_out; p.ws = (unsigned char*)d_ws;
    for (int h = 0; h < 8; ++h) p.lg[h] = (float)std::log2(1.0 - std::exp2(-5.0 - (double)h));
    void* args[] = {&p};
#ifdef SELFCHK
    (void)hipMemsetAsync((unsigned char*)d_ws + WS_DBG, 0, 256, stream);
#endif
    hipError_t e = hipLaunchCooperativeKernel((const void*)mega_fwd, dim3(grid), dim3(512), args, LDS_BYTES, stream);
    if (e != hipSuccess) fprintf(stderr, "kernel_launch: cooperative launch failed: %s (grid %d)\n", hipGetErrorString(e), grid);
#ifdef DBG_ZERO
    hipLaunchKernelGGL(zero_kernel, dim3(256), dim3(512), 0, stream, p);
#endif
#ifdef SELFCHK
    hipLaunchKernelGGL(chk_kernel, dim3(8), dim3(512), 0, stream, p);
    hipLaunchKernelGGL(enc_kernel, dim3(256), dim3(512), 0, stream, p);
#endif
}
```

```cpp
#include <hip/hip_runtime.h>
#include <hip/hip_cooperative_groups.h>
#include <cstdio>
#include <cstdint>
#include <cmath>
namespace cg = cooperative_groups;
namespace pg8 {
#define PG8_LAS __attribute__((address_space(3)))
typedef unsigned short bf16_t;
typedef short bf16x8 __attribute__((ext_vector_type(8)));
typedef float f32x4 __attribute__((ext_vector_type(4)));
typedef unsigned u32x4 __attribute__((ext_vector_type(4)));
constexpr int BM = 256, BK = 64, HALF = 128, HTB = HALF * BK * 2  , STAGE_BYTES = 8 * HTB, NXCD = 8, WGM = 8;

__host__ __device__ __forceinline__ int lds_byte(int r, int c) { const int st = (r >> 4) * 2 + (c >> 5), rr = r & 15, cc = c & 31, ob = rr * 64 + cc * 2; return st * 1024 + (ob ^ (((ob >> 9) & 1) << 5)); }
__host__ __device__ __forceinline__ void stage_rc(int b, int& R, int& C) { const int st = b / 1024, sb = b % 1024, swz = sb ^ (((sb >> 9) & 1) << 5); R = (st >> 1) * 16 + swz / 64; C = (st & 1) * 32 + (swz % 64) / 2; }
__host__ __device__ __forceinline__ int perm32(int rho) { const int n = rho >> 4, i = rho & 15; return 8 * (i >> 2) + 4 * n + (i & 3); }

struct Unit { int pm, pn; };
struct Gemm { const bf16_t* A; const bf16_t* Bt; int M, N, K; };

struct StaticOrder {
    int nM, nN, nwg, G, c;
    __host__ __device__ void init(int M, int N, int G_, int c_) { nM = M / BM; nN = N / BM; nwg = nM * nN; G = G_; c = c_; }
    __host__ __device__ bool next(int i, Unit& u) const {
        const long L = (long)i * G + c; if (L >= nwg) return false;
        int wgid = (int)L; { const int q = nwg / NXCD, r = nwg % NXCD, xcd = wgid % NXCD, off = wgid / NXCD; wgid = (xcd < r ? xcd * (q + 1) : r * (q + 1) + (xcd - r) * q) + off; }
        const int nig = WGM * nN, gid = wgid / nig, fm = gid * WGM, gsz = (nM - fm) < WGM ? (nM - fm) : WGM;
        u.pm = fm + ((wgid % nig) % gsz); u.pn = (wgid % nig) / gsz; return true;
    }
    __device__ __forceinline__ void a_ready(const Unit&) const {}
    __device__ __forceinline__ void done(const Unit&) const {}
};

__device__ __forceinline__ unsigned cvt_pk_bf16(float lo, float hi) { unsigned r; asm volatile("v_cvt_pk_bf16_f32 %0, %1, %2" : "=v"(r) : "v"(lo), "v"(hi)); return r; }
typedef float f32x2 __attribute__((ext_vector_type(2)));
__device__ __forceinline__ f32x2 gelu_pk(f32x2 v) {
    const f32x2 av = __builtin_elementwise_abs(v), d = av * 0.2316418882f + 1.0f;
    f32x2 t; t.x = __builtin_amdgcn_rcpf(d.x); t.y = __builtin_amdgcn_rcpf(d.y);
    f32x2 q = t * 0.5307027145f + (-0.7265760135f); q = q * t + 0.7107068705f; q = q * t + (-0.142248368f); q = q * t + 0.127414796f; q = q * t;
    const f32x2 s = (v * v) * (-0.72134752044f);
    f32x2 e; e.x = __builtin_amdgcn_exp2f(s.x); e.y = __builtin_amdgcn_exp2f(s.y);
    const f32x2 m = v * (q * e), r = v - m;
    f32x2 o; o.x = v.x < 0.f ? m.x : r.x; o.y = v.y < 0.f ? m.y : r.y; return o;
}

template <int ACT  > struct EpiBf16 {
    static constexpr bool PERM = true, AFTER_DRAIN = false; static_assert(ACT == 0 || ACT == 1, "EpiBf16: ACT is 0 (none) or 1 (gelu_pk)");
    bf16_t* O; int ldc; const float* bias; int split_cols; size_t split_stride; float scale0;
    __device__ __forceinline__ void operator()(const f32x4 (&acc)[2][2][4][2], const Unit& u, int wr, int wc, int fr, int fq) const {
        const int row0 = u.pm * BM + wr * 64 + fr; int colt = u.pn * BM; bf16_t* base = O;
        float sc = 1.f; if (split_cols) { const int t = colt / split_cols; base += (size_t)t * split_stride; colt -= t * split_cols; if (t == 0) sc = scale0; }
        const int col0 = colt + wc * 32 + 8 * fq, bcol0 = u.pn * BM + wc * 32 + 8 * fq;
        f32x4 bv[2][2];
#pragma unroll
        for (int bj = 0; bj < 2; ++bj)
#pragma unroll
            for (int n = 0; n < 2; ++n) bv[bj][n] = bias ? *(const f32x4*)(bias + bcol0 + bj * HALF + 4 * n) : (f32x4){0.f, 0.f, 0.f, 0.f};
#pragma unroll
        for (int ai = 0; ai < 2; ++ai)
#pragma unroll
            for (int m = 0; m < 4; ++m) { bf16_t* rowp = base + (size_t)(row0 + ai * HALF + m * 16) * ldc + col0;
#pragma unroll
                for (int bj = 0; bj < 2; ++bj) { f32x4 v0 = acc[ai][bj][m][0] + bv[bj][0], v1 = acc[ai][bj][m][1] + bv[bj][1];
                    if (ACT == 1) { f32x2 a = gelu_pk((f32x2){v0[0], v0[1]}), b = gelu_pk((f32x2){v0[2], v0[3]}), c = gelu_pk((f32x2){v1[0], v1[1]}), d = gelu_pk((f32x2){v1[2], v1[3]});
                        v0 = (f32x4){a.x, a.y, b.x, b.y}; v1 = (f32x4){c.x, c.y, d.x, d.y}; }
                    v0 = v0 * sc; v1 = v1 * sc; u32x4 w; w.x = cvt_pk_bf16(v0[0], v0[1]); w.y = cvt_pk_bf16(v0[2], v0[3]); w.z = cvt_pk_bf16(v1[0], v1[1]); w.w = cvt_pk_bf16(v1[2], v1[3]);
                    *(u32x4*)(rowp + bj * HALF) = w; } }
    }
};

struct PanelStats {
    unsigned* xbuf;
    unsigned* cnt;
    unsigned* tmo;
    int ntn; float eps;
    unsigned code;
    __device__ __forceinline__ bool run(const f32x4 (&v)[2][2][4][2], const Unit& u, int wr, int wc, int fr, int fq, PG8_LAS unsigned char* lds, int wid, int lane) const {
        typedef float f32x2v __attribute__((ext_vector_type(2)));
        PG8_LAS f32x2v* P = (PG8_LAS f32x2v*)lds;
        PG8_LAS f32x2v* S = (PG8_LAS f32x2v*)(lds + 8192);
        PG8_LAS unsigned* flag = (PG8_LAS unsigned*)(lds + 8192 + 2048);
#pragma unroll
        for (int ai = 0; ai < 2; ++ai)
#pragma unroll
            for (int m = 0; m < 4; ++m) {
                float s = 0.f;
#pragma unroll
                for (int bj = 0; bj < 2; ++bj)
#pragma unroll
                    for (int n = 0; n < 2; ++n) { const f32x4 x = v[ai][bj][m][n]; s += (x[0] + x[1]) + (x[2] + x[3]); }
                s += __shfl_xor(s, 16); s += __shfl_xor(s, 32);
                const float mw = s * (1.0f / 64.0f); float q = 0.f;
#pragma unroll
                for (int bj = 0; bj < 2; ++bj)
#pragma unroll
                    for (int n = 0; n < 2; ++n) { const f32x4 d = v[ai][bj][m][n] - mw; q += (d[0] * d[0] + d[1] * d[1]) + (d[2] * d[2] + d[3] * d[3]); }
                q += __shfl_xor(q, 16); q += __shfl_xor(q, 32);
                if (fq == 0) P[(ai * HALF + wr * 64 + m * 16 + fr) * 4 + wc] = (f32x2v){mw, q};
            }
        asm volatile("s_waitcnt lgkmcnt(0)" ::: "memory"); __builtin_amdgcn_s_barrier(); asm volatile("" ::: "memory");
#if defined(BROKEN_EXCHANGE_NO_WAIT)
#warning BROKEN CONTROL BUILD: the row-statistics exchange does not wait; results are wrong by design
        if (blockIdx.x >= 64) { const long long t0_ = clock64(); while (clock64() - t0_ < 60000) __builtin_amdgcn_s_sleep(8); }
#endif
        const int row = wid * 32 + (lane & 31);
        if (lane < 32) {
            const f32x2v a = P[row * 4 + 0], b = P[row * 4 + 1], c = P[row * 4 + 2], d = P[row * 4 + 3];
            const float mt = (a.x + b.x + c.x + d.x) * 0.25f;
            const float da = a.x - mt, db = b.x - mt, dc = c.x - mt, dd = d.x - mt;
            const float m2 = (a.y + b.y) + (c.y + d.y) + 64.0f * ((da * da + db * db) + (dc * dc + dd * dd));
            unsigned long long* slot = (unsigned long long*)xbuf + ((size_t)(u.pm * BM + row) * 4 + u.pn);
            __hip_atomic_store(slot, ((unsigned long long)__float_as_uint(m2) << 32) | __float_as_uint(mt), __ATOMIC_RELAXED, __HIP_MEMORY_SCOPE_AGENT);
        }
        asm volatile("s_waitcnt vmcnt(0)" ::: "memory");
        if (lane == 0) __hip_atomic_fetch_add(cnt + 64 * u.pm, 1u, __ATOMIC_RELAXED, __HIP_MEMORY_SCOPE_AGENT);
        if (wid == 0) {
            bool dead = false; const unsigned long long t0 = __builtin_amdgcn_s_memrealtime(); const unsigned want = 8u * (unsigned)ntn;
            for (;;) {
#if defined(BROKEN_EXCHANGE_NO_WAIT)
                break;
#endif
                if ((unsigned)__builtin_amdgcn_readfirstlane(__hip_atomic_load(cnt + 64 * u.pm, __ATOMIC_RELAXED, __HIP_MEMORY_SCOPE_AGENT)) >= want) break;
                if (__builtin_amdgcn_s_memrealtime() - t0 > 2000000ull) {
                    if (lane == 0) { unsigned expect = 0u; __hip_atomic_compare_exchange_strong(tmo + 1, &expect, code | (unsigned)(u.pm & 0xff), __ATOMIC_RELAXED, __ATOMIC_RELAXED, __HIP_MEMORY_SCOPE_AGENT);
                                     __hip_atomic_store(tmo, 1u, __ATOMIC_RELAXED, __HIP_MEMORY_SCOPE_AGENT); }
                    dead = true; break; }
                __builtin_amdgcn_s_sleep(2);
            }
            __builtin_amdgcn_fence(__ATOMIC_ACQUIRE, "agent");
            if (lane == 0) flag[0] = dead ? 1u : 0u;
        }
        asm volatile("s_waitcnt vmcnt(0) lgkmcnt(0)" ::: "memory"); __builtin_amdgcn_s_barrier(); asm volatile("" ::: "memory");
        const bool bad = flag[0] != 0u;
        if (lane < 32) {
            const unsigned long long* slot = (const unsigned long long*)xbuf + (size_t)(u.pm * BM + row) * 4; float mt[4], m2[4]; float ms = 0.f;
#pragma unroll
            for (int t = 0; t < 4; ++t) { if (t < ntn) { const unsigned long long w = __hip_atomic_load(slot + t, __ATOMIC_RELAXED, __HIP_MEMORY_SCOPE_AGENT); mt[t] = __uint_as_float((unsigned)w); m2[t] = __uint_as_float((unsigned)(w >> 32)); } else { mt[t] = 0.f; m2[t] = 0.f; } ms += mt[t]; }
            const float mean = ms / (float)ntn; float q = 0.f;
#pragma unroll
            for (int t = 0; t < 4; ++t) if (t < ntn) { const float dm = mt[t] - mean; q += m2[t] + 256.0f * dm * dm; }
            S[row] = (f32x2v){mean, 1.0f / sqrtf(q / (256.0f * (float)ntn) + eps)};
        }
        asm volatile("s_waitcnt lgkmcnt(0)" ::: "memory"); __builtin_amdgcn_s_barrier(); asm volatile("" ::: "memory");
        return bad;
    }
};
struct EpiLnRes {
    static constexpr bool PERM = false, AFTER_DRAIN = true;
    const float* base; float* out; int ldc; const float* bias; PanelStats st; unsigned poison;
    __device__ __forceinline__ void fused(f32x4 (&acc)[2][2][4][2], const Unit& u, int wr, int wc, int fr, int fq, PG8_LAS unsigned char* lds, int wid, int lane) const {
        typedef float f32x2v __attribute__((ext_vector_type(2)));
        const PG8_LAS f32x2v* S = (const PG8_LAS f32x2v*)(lds + 8192);
        const int col0 = u.pn * BM + wc * 32 + 4 * fq;
#pragma unroll
        for (int bj = 0; bj < 2; ++bj)
#pragma unroll
            for (int n = 0; n < 2; ++n) { const f32x4 bv = bias ? *(const f32x4*)(bias + col0 + bj * HALF + n * 16) : (f32x4){0.f, 0.f, 0.f, 0.f};
#pragma unroll
                for (int ai = 0; ai < 2; ++ai)
#pragma unroll
                    for (int m = 0; m < 4; ++m) acc[ai][bj][m][n] += bv; }
        f32x4 pre[4][2][2];
#pragma unroll
        for (int m = 0; m < 4; ++m) { const size_t off = (size_t)(u.pm * BM + wr * 64 + m * 16 + fr) * ldc + col0;
#pragma unroll
            for (int bj = 0; bj < 2; ++bj)
#pragma unroll
                for (int n = 0; n < 2; ++n) pre[m][bj][n] = *(const f32x4*)(base + off + bj * HALF + n * 16); }
        const bool bad = st.run(acc, u, wr, wc, fr, fq, lds, wid, lane) || poison != 0u;
        const float qnan = __builtin_nanf("");
#pragma unroll
        for (int ai = 0; ai < 2; ++ai)
#pragma unroll
            for (int m = 0; m < 4; ++m) { const int r = ai * HALF + wr * 64 + m * 16 + fr; const f32x2v sr = S[r]; const size_t off = (size_t)(u.pm * BM + r) * ldc + col0;
#pragma unroll
                for (int bj = 0; bj < 2; ++bj)
#pragma unroll
                    for (int n = 0; n < 2; ++n) { const f32x4 bs = ai == 0 ? pre[m][bj][n] : *(const f32x4*)(base + off + bj * HALF + n * 16); f32x4 o = bs + (acc[ai][bj][m][n] - sr.x) * sr.y;
                        if (bad) o = (f32x4){qnan, qnan, qnan, qnan}; *(f32x4*)(out + off + bj * HALF + n * 16) = o; }
                if (m & 1) asm volatile("" ::: "memory"); }
    }
};
struct EpiLnResLn {
    static constexpr bool PERM = false, AFTER_DRAIN = true;
    const float* base; float* out; bf16_t* xn; int ldc; const float* bias; PanelStats st1, st2; unsigned poison;
    __device__ __forceinline__ void fused(f32x4 (&acc)[2][2][4][2], const Unit& u, int wr, int wc, int fr, int fq, PG8_LAS unsigned char* lds, int wid, int lane) const {
        typedef float f32x2v __attribute__((ext_vector_type(2))); typedef unsigned u32x2v __attribute__((ext_vector_type(2)));
        const PG8_LAS f32x2v* S = (const PG8_LAS f32x2v*)(lds + 8192);
        const int col0 = u.pn * BM + wc * 32 + 4 * fq;
#pragma unroll
        for (int bj = 0; bj < 2; ++bj)
#pragma unroll
            for (int n = 0; n < 2; ++n) { const f32x4 bv = bias ? *(const f32x4*)(bias + col0 + bj * HALF + n * 16) : (f32x4){0.f, 0.f, 0.f, 0.f};
#pragma unroll
                for (int ai = 0; ai < 2; ++ai)
#pragma unroll
                    for (int m = 0; m < 4; ++m) acc[ai][bj][m][n] += bv; }
        bool bad = st1.run(acc, u, wr, wc, fr, fq, lds, wid, lane) || poison != 0u;
        const float qnan = __builtin_nanf("");
#pragma unroll
        for (int ai = 0; ai < 2; ++ai)
#pragma unroll
            for (int m = 0; m < 4; ++m) { const int r = ai * HALF + wr * 64 + m * 16 + fr; const f32x2v sr = S[r]; const size_t off = (size_t)(u.pm * BM + r) * ldc + col0;
#pragma unroll
                for (int bj = 0; bj < 2; ++bj)
#pragma unroll
                    for (int n = 0; n < 2; ++n) { const f32x4 bs = *(const f32x4*)(base + off + bj * HALF + n * 16); acc[ai][bj][m][n] = bs + (acc[ai][bj][m][n] - sr.x) * sr.y; }
                asm volatile("" : "+v"(acc[ai][0][m][0]), "+v"(acc[ai][0][m][1]), "+v"(acc[ai][1][m][0]), "+v"(acc[ai][1][m][1]));
                if (m & 1) asm volatile("" ::: "memory"); }
        const bool bad1 = bad;
        bad = st2.run(acc, u, wr, wc, fr, fq, lds, wid, lane) || bad;
#pragma unroll
        for (int ai = 0; ai < 2; ++ai)
#pragma unroll
            for (int m = 0; m < 4; ++m) { const int r = ai * HALF + wr * 64 + m * 16 + fr; const f32x2v sr = S[r]; const size_t off = (size_t)(u.pm * BM + r) * ldc + col0;
#pragma unroll
                for (int bj = 0; bj < 2; ++bj)
#pragma unroll
                    for (int n = 0; n < 2; ++n) { const f32x4 x1 = acc[ai][bj][m][n]; *(f32x4*)(out + off + bj * HALF + n * 16) = bad1 ? (f32x4){qnan, qnan, qnan, qnan} : x1;
                        const f32x4 o = (x1 - sr.x) * sr.y; u32x2v w; w.x = cvt_pk_bf16(o[0], o[1]); w.y = cvt_pk_bf16(o[2], o[3]);
                        if (bad) { w.x = 0x7fc07fc0u; w.y = 0x7fc07fc0u; } *(u32x2v*)(xn + off + bj * HALF + n * 16) = w; }
                asm volatile("" ::: "memory"); }
    }
};

template <class Epi, class Sched, bool ALIGN_EPI = false, bool SP2 = false>
__device__ __forceinline__ void gemm_phase(PG8_LAS unsigned char* lds, const Gemm g, const Sched& S, const Epi& E) {
    int tid_h = threadIdx.x; asm volatile("" : "+v"(tid_h));
    const int tid = tid_h, wid = __builtin_amdgcn_readfirstlane(tid >> 6), lane = tid & 63, wr = wid >> 2, wc = wid & 3, fr = lane & 15, fq = lane >> 4;
    const int K = g.K, nt = K / BK;
    unsigned voffA[2], voffB[2];
#pragma unroll
    for (int i = 0; i < 2; ++i) { int R, C; stage_rc(tid * 16 + i * 8192, R, C); const int Rb = Epi::PERM ? ((R & ~31) + perm32(R & 31)) : R;
        voffA[i] = (unsigned)(R * K + C) * 2u; voffB[i] = (unsigned)(Rb * K + C) * 2u; }
    const size_t kstep = (size_t)(BK * 2);
    const size_t hstep = (size_t)HALF * K * 2;
    const size_t tstep = 2 * hstep;
    const unsigned ldsw = (unsigned)wid * 1024u;
    const int aoff = lds_byte(wr * 64 + fr, fq * 8), boff = lds_byte(wc * 32 + fr, fq * 8);
#define PG8_SA(b, h) (((b) * 2 + (h)) * HTB)
#define PG8_SB(b, h) ((4 + (b) * 2 + (h)) * HTB)
#define PG8_STAGE(bufoff, gbase, voff) do { _Pragma("unroll") for (int _i = 0; _i < 2; ++_i) \
        __builtin_amdgcn_global_load_lds((const unsigned*)((const char*)(gbase) + (voff)[_i]), (PG8_LAS unsigned*)(lds + (bufoff) + ldsw + _i * 8192), 16, 0, 0); } while (0)
#define PG8_LDA(dst, b, h) do { _Pragma("unroll") for (int m = 0; m < 4; ++m) _Pragma("unroll") for (int k = 0; k < 2; ++k) dst[m][k] = *(const PG8_LAS bf16x8*)(lds + PG8_SA(b, h) + aoff + m * 2048 + k * 1024); } while (0)
#define PG8_LDB(dst, b, h) do { _Pragma("unroll") for (int n = 0; n < 2; ++n) _Pragma("unroll") for (int k = 0; k < 2; ++k) dst[n][k] = *(const PG8_LAS bf16x8*)(lds + PG8_SB(b, h) + boff + n * 2048 + k * 1024); } while (0)
#define PG8_MMA(ai, bj, At, Bt) do { __builtin_amdgcn_s_setprio(1); _Pragma("unroll") for (int m = 0; m < 4; ++m) _Pragma("unroll") for (int n = 0; n < 2; ++n) _Pragma("unroll") for (int k = 0; k < 2; ++k) \
        acc[ai][bj][m][n] = __builtin_amdgcn_mfma_f32_16x16x32_bf16(Bt[n][k], At[m][k], acc[ai][bj][m][n], 0, 0, 0); __builtin_amdgcn_s_setprio(0); } while (0)
#define PG8_WAIT_V(n) asm volatile("s_waitcnt vmcnt(" #n ")" ::: "memory")
#define PG8_WAIT_L(n) asm volatile("s_waitcnt lgkmcnt(" #n ")" ::: "memory")
#define PG8_BAR __builtin_amdgcn_s_barrier()
#define PG8_SCHED __builtin_amdgcn_sched_barrier(0)
    Unit cur, nxt; int ui = 0;
    if (!S.next(0, cur)) return;
    f32x4 acc[2][2][4][2];
#pragma unroll
    for (int a = 0; a < 2; ++a)
#pragma unroll
        for (int b = 0; b < 2; ++b)
#pragma unroll
            for (int m = 0; m < 4; ++m)
#pragma unroll
                for (int n = 0; n < 2; ++n) acc[a][b][m][n] = (f32x4){0.f, 0.f, 0.f, 0.f};
    bf16x8 At[4][2], B0[2][2], B1[2][2];
    const char* cA = (const char*)g.A + (size_t)cur.pm * tstep; const char* cB = (const char*)g.Bt + (size_t)cur.pn * tstep;
    S.a_ready(cur);
    if constexpr (SP2) {
        PG8_STAGE(PG8_SB(0, 0), cB, voffB); PG8_STAGE(PG8_SB(0, 1), cB + hstep, voffB); PG8_STAGE(PG8_SA(0, 0), cA, voffA); PG8_STAGE(PG8_SA(0, 1), cA + hstep, voffA);
        if (wr == 1) PG8_BAR;
        PG8_WAIT_V(2); PG8_BAR;
        PG8_STAGE(PG8_SB(1, 0), cB + kstep, voffB); PG8_STAGE(PG8_SA(1, 0), cA + kstep, voffA); PG8_STAGE(PG8_SB(1, 1), cB + hstep + kstep, voffB);
        PG8_WAIT_V(6); PG8_BAR;
    } else {
        PG8_STAGE(PG8_SB(0, 0), cB, voffB); PG8_STAGE(PG8_SA(0, 0), cA, voffA); PG8_STAGE(PG8_SB(0, 1), cB + hstep, voffB); PG8_STAGE(PG8_SA(0, 1), cA + hstep, voffA);
        if (wr == 1) PG8_BAR;
        PG8_WAIT_V(4); PG8_BAR;
        PG8_STAGE(PG8_SB(1, 0), cB + kstep, voffB); PG8_STAGE(PG8_SA(1, 0), cA + kstep, voffA); PG8_STAGE(PG8_SB(1, 1), cB + hstep + kstep, voffB);
        PG8_WAIT_V(6); PG8_BAR;
    }
    for (;;) {
        const bool has_next = S.next(ui + 1, nxt);
        const char* nA = has_next ? (const char*)g.A + (size_t)nxt.pm * tstep : cA; const char* nB = has_next ? (const char*)g.Bt + (size_t)nxt.pn * tstep : cB;
        for (int t = 0; t < nt; t += 2) {
            const bool last = (t == nt - 2);
            const char* a1 = cA + (size_t)(t + 1) * kstep;
            const char* a2 = last ? nA : cA + (size_t)(t + 2) * kstep; const char* b2 = last ? nB : cB + (size_t)(t + 2) * kstep;
            const char* a3 = a2 + kstep; const char* b3 = b2 + kstep;
            if (last && has_next) S.a_ready(nxt);
            if constexpr (SP2) {
            PG8_LDB(B0, 0, 0); PG8_LDB(B1, 0, 1); PG8_SCHED; PG8_LDA(At, 0, 0); PG8_STAGE(PG8_SA(1, 1), a1 + hstep, voffA);
            PG8_WAIT_V(8); PG8_WAIT_L(0); PG8_BAR; PG8_MMA(0, 0, At, B0); PG8_MMA(0, 1, At, B1); PG8_BAR; PG8_SCHED;
            PG8_LDA(At, 0, 1); PG8_STAGE(PG8_SB(0, 0), b2, voffB); PG8_STAGE(PG8_SB(0, 1), b2 + hstep, voffB); PG8_STAGE(PG8_SA(0, 0), a2, voffA);
            PG8_WAIT_V(8); PG8_WAIT_L(0); PG8_BAR; PG8_MMA(1, 0, At, B0); PG8_MMA(1, 1, At, B1); PG8_BAR; PG8_SCHED;
            PG8_LDB(B0, 1, 0); PG8_LDB(B1, 1, 1); PG8_SCHED; PG8_LDA(At, 1, 0); PG8_STAGE(PG8_SA(0, 1), a2 + hstep, voffA);
            PG8_WAIT_V(8); PG8_WAIT_L(0); PG8_BAR; PG8_MMA(0, 0, At, B0); PG8_MMA(0, 1, At, B1); PG8_BAR; PG8_SCHED;
            PG8_LDA(At, 1, 1); PG8_STAGE(PG8_SB(1, 0), b3, voffB); PG8_STAGE(PG8_SB(1, 1), b3 + hstep, voffB); PG8_STAGE(PG8_SA(1, 0), a3, voffA);
            PG8_WAIT_V(8); PG8_WAIT_L(0); PG8_BAR; PG8_MMA(1, 0, At, B0); PG8_MMA(1, 1, At, B1); PG8_BAR; PG8_SCHED;
            } else {
            PG8_LDB(B0, 0, 0); PG8_SCHED; PG8_LDA(At, 0, 0); PG8_STAGE(PG8_SA(1, 1), a1 + hstep, voffA);
            PG8_WAIT_L(8); PG8_BAR; PG8_WAIT_L(0); PG8_MMA(0, 0, At, B0); PG8_BAR; PG8_SCHED;
            PG8_LDB(B1, 0, 1); PG8_STAGE(PG8_SB(0, 0), b2, voffB);
            PG8_BAR; PG8_WAIT_L(0); PG8_MMA(0, 1, At, B1); PG8_BAR;
            PG8_LDA(At, 0, 1); PG8_STAGE(PG8_SA(0, 0), a2, voffA);
            PG8_BAR; PG8_WAIT_L(0); PG8_MMA(1, 0, At, B0); PG8_BAR; PG8_SCHED;
            PG8_STAGE(PG8_SB(0, 1), b2 + hstep, voffB);
            PG8_WAIT_V(6); PG8_BAR; PG8_MMA(1, 1, At, B1); PG8_BAR;
            PG8_LDB(B0, 1, 0); PG8_SCHED; PG8_LDA(At, 1, 0); PG8_STAGE(PG8_SA(0, 1), a2 + hstep, voffA);
            PG8_WAIT_L(8); PG8_BAR; PG8_WAIT_L(0); PG8_MMA(0, 0, At, B0); PG8_BAR; PG8_SCHED;
            PG8_LDB(B1, 1, 1); PG8_STAGE(PG8_SB(1, 0), b3, voffB);
            PG8_BAR; PG8_WAIT_L(0); PG8_MMA(0, 1, At, B1); PG8_BAR;
            PG8_LDA(At, 1, 1); PG8_STAGE(PG8_SA(1, 0), a3, voffA);
            PG8_BAR; PG8_WAIT_L(0); PG8_MMA(1, 0, At, B0); PG8_BAR; PG8_SCHED;
            PG8_STAGE(PG8_SB(1, 1), b3 + hstep, voffB);
            PG8_WAIT_V(6); PG8_BAR; PG8_MMA(1, 1, At, B1); PG8_BAR;
            }
        }
        if constexpr (ALIGN_EPI) { if (wr == 0) PG8_BAR; }
        if constexpr (!Epi::AFTER_DRAIN) { E(acc, cur, wr, wc, fr, fq); S.done(cur); }
        if (!has_next) break;
#pragma unroll
        for (int a = 0; a < 2; ++a)
#pragma unroll
            for (int b = 0; b < 2; ++b)
#pragma unroll
                for (int m = 0; m < 4; ++m)
#pragma unroll
                    for (int n = 0; n < 2; ++n) acc[a][b][m][n] = (f32x4){0.f, 0.f, 0.f, 0.f};
        cur = nxt; cA = nA; cB = nB; ++ui;
        if constexpr (ALIGN_EPI) { if (wr == 1) PG8_BAR; }
    }
    PG8_WAIT_V(0);
    if constexpr (!ALIGN_EPI) { if (wr == 0) PG8_BAR; }
    PG8_BAR;
    if constexpr (Epi::AFTER_DRAIN) { E.fused(acc, cur, wr, wc, fr, fq, lds, wid, lane); S.done(cur); }
#undef PG8_SA
#undef PG8_SB
#undef PG8_STAGE
#undef PG8_LDA
#undef PG8_LDB
#undef PG8_MMA
#undef PG8_WAIT_V
#undef PG8_WAIT_L
#undef PG8_BAR
#undef PG8_SCHED
}
}

#define LAS __attribute__((address_space(3)))
#define GAS __attribute__((address_space(1)))
using pg8::bf16_t; using pg8::bf16x8; using pg8::f32x4; using pg8::u32x4; using pg8::Unit; using pg8::Gemm;
typedef float f32x16 __attribute__((ext_vector_type(16)));
typedef short s16x4 __attribute__((ext_vector_type(4)));
typedef unsigned u32x2 __attribute__((ext_vector_type(2)));
typedef float f32x2 __attribute__((ext_vector_type(2)));
typedef __bf16 bf16x2_t __attribute__((ext_vector_type(2)));
typedef short v4i16_t __attribute__((ext_vector_type(4)));
typedef LAS const char* lds_cptr;

constexpr int NB = 4, SEQ = 8192, DM = 1024, NDB = 8, LDEC = 32, PAST = 2048, KALL = PAST + LDEC;
constexpr int MP = NB * SEQ;
constexpr int MS = NDB * LDEC;
constexpr int MT = MP + MS;
constexpr int KR = MP + NDB * KALL;
constexpr int NIN = 2304, NRAW = 1280, DFF = 4096;
constexpr int NITEM_P = NB * 8 * (SEQ / 64), NITEM = NITEM_P + NDB * 8;
constexpr float EPS = 1e-6f;
constexpr float QSCALE = 0.10206207261596575f * 1.4426950408889634f;
constexpr float RK_SCALE = 0.17677669529663687f;

constexpr size_t O_Y = 0;
constexpr size_t O_CKVP = (size_t)MT * 1024;
constexpr size_t O_KRP = O_CKVP + (size_t)2 * MP * 256;
constexpr size_t O_RETP = O_KRP + (size_t)2 * MP * 32;
constexpr size_t O_CKVS = O_RETP + (size_t)2 * NB * 8 * 32 * 64;
constexpr size_t O_KRS = O_CKVS + (size_t)2 * MS * 256;
constexpr size_t O_RETS = O_KRS + (size_t)2 * MS * 32;
constexpr size_t O_END = O_RETS + (size_t)2 * NDB * 8 * 32 * 64;

constexpr size_t MiB = 1u << 20;
constexpr size_t WL_IN = 0, WL_UQ = WL_IN + (size_t)NIN * 1024 * 2, WL_UKV = WL_UQ + (size_t)768 * 384 * 2, WL_OUT = WL_UKV + (size_t)1024 * 256 * 2,
                 WL_FF1 = WL_OUT + (size_t)1024 * 1024 * 2, WL_FF2 = WL_FF1 + (size_t)4096 * 1024 * 2, WL_GATE = WL_FF2 + (size_t)4096 * 1024 * 2,
                 WL_PROJ = WL_GATE + (size_t)1024 * 1024 * 2, WL_END = WL_PROJ + (size_t)1024 * 256 * 2;
constexpr size_t WL_STRIDE = 27 * MiB;
static_assert(WL_END <= WL_STRIDE, "weights per layer");
constexpr size_t WS_TAB = 54 * MiB;
constexpr size_t WS_SSQ = 55 * MiB + 65536;
static_assert(WS_SSQ + (size_t)6 * MT * 4 <= 56 * MiB, "ssq");
constexpr size_t WS_A = 56 * MiB;
constexpr size_t SZ_ROW1K = (size_t)MT * 1024 * 2;
constexpr size_t WS_Q = WS_A, WS_RQ = WS_A + (size_t)MT * 768 * 2;
constexpr size_t WS_MIX = WS_A + SZ_ROW1K;
constexpr size_t WS_PG = WS_MIX + SZ_ROW1K;
constexpr size_t WS_V = WS_PG, WS_RK = WS_PG + (size_t)KR * 512 * 2;
static_assert(WS_RK + (size_t)MT * 256 * 2 <= WS_PG + SZ_ROW1K, "V|RK overlay");
constexpr size_t WS_U = WS_PG + SZ_ROW1K;
constexpr size_t WS_RVG = WS_U;
constexpr size_t WS_RAW = WS_RVG + SZ_ROW1K;
constexpr size_t WS_KNOPE = WS_RAW, WS_PBF = WS_RAW;
constexpr size_t WS_QL = WS_RAW + (size_t)MT * NRAW * 2;
constexpr size_t WS_CKV = WS_QL + (size_t)MT * 384 * 2;
constexpr size_t WS_KVT = WS_CKV + (size_t)KR * 256 * 2;
constexpr size_t WS_ST = WS_KVT + (size_t)NITEM * 2048 * 4;
constexpr size_t WS_KRB = WS_ST + (size_t)NITEM * 2048 * 2;
constexpr size_t WS_UEND = WS_KRB + (size_t)KR * 32 * 2;
constexpr size_t WS_END = WS_U + (size_t)MT * DFF * 2;
static_assert(WS_UEND <= WS_END, "U overlay");
static_assert((size_t)KR * 512 * 2 <= (size_t)MT * NRAW * 2, "KNOPE overlay");
static_assert(WS_END <= 512 * MiB, "workspace");

#ifndef PHMASK
#define PHMASK 0xFFFF
#endif
#ifndef DUPMASK
#define DUPMASK 0
#endif
#ifndef DUP_SCAN
#define DUP_SCAN 0
#endif
#ifndef DUP_PROMPT
#define DUP_PROMPT 0
#endif
#ifndef DUP_SAMPLE
#define DUP_SAMPLE 0
#endif
constexpr int LDS_BYTES = 131072 + 1024;

struct Params {
    const float* in[22];
    float* out;
    unsigned char* ws;
};

#define MFMA32(a, b, c) __builtin_amdgcn_mfma_f32_32x32x16_bf16((a), (b), (c), 0, 0, 0)
__device__ __forceinline__ unsigned cvtpk(float lo, float hi) { f32x2 v = {lo, hi}; bf16x2_t b = __builtin_convertvector(v, bf16x2_t); return __builtin_bit_cast(unsigned, b); }
__device__ __forceinline__ float bflo(unsigned u) { return __uint_as_float(u << 16); }
__device__ __forceinline__ float bfhi(unsigned u) { return __uint_as_float(u & 0xffff0000u); }
__device__ __forceinline__ int crow(int r, int hi) { return (r & 3) + 8 * (r >> 2) + 4 * hi; }
__device__ __forceinline__ float wave_sum(float v) {
#pragma unroll
    for (int o = 1; o < 64; o <<= 1) v += __shfl_xor(v, o);
    return v;
}
__device__ __forceinline__ s16x4 vtr(lds_cptr p) { return __builtin_bit_cast(s16x4, __builtin_amdgcn_ds_read_tr16_b64_v4i16((LAS v4i16_t*)p)); }
__device__ __forceinline__ bf16x8 cat8(s16x4 lo, s16x4 hi) { return (bf16x8){lo[0], lo[1], lo[2], lo[3], hi[0], hi[1], hi[2], hi[3]}; }
__device__ __forceinline__ bf16x8 pack8(const f32x16& x, int s) {
    u32x4 p; p.x = cvtpk(x[8 * s + 0], x[8 * s + 1]); p.y = cvtpk(x[8 * s + 2], x[8 * s + 3]); p.z = cvtpk(x[8 * s + 4], x[8 * s + 5]); p.w = cvtpk(x[8 * s + 6], x[8 * s + 7]);
    return __builtin_bit_cast(bf16x8, p);
}
__device__ __forceinline__ float lg_of(int h) { const float x = __builtin_amdgcn_exp2f(-5.f - (float)h); const float sr = x * (1.f + x * (0.5f + x * (0.33333334f + x * (0.25f + x * (0.2f + x * 0.16666667f))))); return -sr * 1.4426950408889634f; }
__device__ __forceinline__ unsigned char* hide_ptr(unsigned char* p) { asm volatile("" : "+s"(p)); return p; }
__device__ __forceinline__ int tok_pos(int row) { return row < MP ? (row & (SEQ - 1)) : PAST + ((row - MP) & (LDEC - 1)); }

__device__ __forceinline__ float rstd_of(const float* ssq, int row) { return ssq ? rsqrtf(ssq[row] * (1.f / 1024.f) + EPS) : 1.f; }
struct EpiIn {
    static constexpr bool PERM = true, AFTER_DRAIN = false;
    bf16_t* raw; bf16_t* rvg; const float* ssq;
    __device__ __forceinline__ void operator()(const f32x4 (&acc)[2][2][4][2], const Unit& u, int wr, int wc, int fr, int fq) const {
        const int row0 = u.pm * 256 + wr * 64 + fr; const int colt = u.pn * 256;
        bf16_t* base; int ldc, cb;
        if (colt < NRAW) { base = raw; ldc = NRAW; cb = colt; } else { base = rvg; ldc = 1024; cb = colt - NRAW; }
        const int col0 = cb + wc * 32 + 8 * fq;
#pragma unroll
        for (int ai = 0; ai < 2; ++ai)
#pragma unroll
            for (int m = 0; m < 4; ++m) { bf16_t* rowp = base + (size_t)(row0 + ai * 128 + m * 16) * ldc + col0; const float rs = rstd_of(ssq, row0 + ai * 128 + m * 16);
#pragma unroll
                for (int bj = 0; bj < 2; ++bj) { const f32x4 v0 = acc[ai][bj][m][0] * rs, v1 = acc[ai][bj][m][1] * rs;
                    u32x4 w; w.x = cvtpk(v0[0], v0[1]); w.y = cvtpk(v0[2], v0[3]); w.z = cvtpk(v1[0], v1[1]); w.w = cvtpk(v1[2], v1[3]);
                    *(GAS u32x4*)(rowp + bj * 128) = w; } }
    }
};
struct EpiUq {
    static constexpr bool PERM = true, AFTER_DRAIN = false;
    bf16_t* Q; const float* tab;
    __device__ __forceinline__ void operator()(const f32x4 (&acc)[2][2][4][2], const Unit& u, int wr, int wc, int fr, int fq) const {
        const int row0 = u.pm * 256 + wr * 64 + fr;
#pragma unroll
        for (int ai = 0; ai < 2; ++ai)
#pragma unroll
            for (int m = 0; m < 4; ++m) { const int row = row0 + ai * 128 + m * 16; bf16_t* rowp = Q + (size_t)row * 768;
#pragma unroll
                for (int bj = 0; bj < 2; ++bj) { const int c = u.pn * 256 + bj * 128 + wc * 32 + 8 * fq; f32x4 v0 = acc[ai][bj][m][0], v1 = acc[ai][bj][m][1]; int dst;
                    if (u.pn < 2) { dst = (c >> 6) * 96 + (c & 63); }
                    else { const int i = c - 512, hh = i >> 5, w0 = i & 31; dst = hh * 96 + 64 + w0;
                        const float* tp = tab + ((size_t)tok_pos(row) * 16 + (w0 >> 1)) * 2;
                        const f32x4 t0 = *(const GAS f32x4*)tp, t1 = *(const GAS f32x4*)(tp + 4);
                        f32x4 a, b;
                        a[0] = v0[0] * t0[0] - v0[1] * t0[1]; a[1] = v0[0] * t0[1] + v0[1] * t0[0];
                        a[2] = v0[2] * t0[2] - v0[3] * t0[3]; a[3] = v0[2] * t0[3] + v0[3] * t0[2];
                        b[0] = v1[0] * t1[0] - v1[1] * t1[1]; b[1] = v1[0] * t1[1] + v1[1] * t1[0];
                        b[2] = v1[2] * t1[2] - v1[3] * t1[3]; b[3] = v1[2] * t1[3] + v1[3] * t1[2];
                        v0 = a; v1 = b; }
                    v0 = v0 * QSCALE; v1 = v1 * QSCALE;
                    u32x4 w; w.x = cvtpk(v0[0], v0[1]); w.y = cvtpk(v0[2], v0[3]); w.z = cvtpk(v1[0], v1[1]); w.w = cvtpk(v1[2], v1[3]);
                    *(GAS u32x4*)(rowp + dst) = w; }
                asm volatile("" ::: "memory"); }
    }
};
struct EpiUkv {
    static constexpr bool PERM = true, AFTER_DRAIN = false;
    bf16_t* KN; bf16_t* V;
    __device__ __forceinline__ void operator()(const f32x4 (&acc)[2][2][4][2], const Unit& u, int wr, int wc, int fr, int fq) const {
        const int row0 = u.pm * 256 + wr * 64 + fr;
        bf16_t* base = (u.pn < 2) ? KN : V; const int col0 = (u.pn & 1) * 256 + wc * 32 + 8 * fq;
#pragma unroll
        for (int ai = 0; ai < 2; ++ai)
#pragma unroll
            for (int m = 0; m < 4; ++m) { bf16_t* rowp = base + (size_t)(row0 + ai * 128 + m * 16) * 512 + col0;
#pragma unroll
                for (int bj = 0; bj < 2; ++bj) { const f32x4 v0 = acc[ai][bj][m][0], v1 = acc[ai][bj][m][1];
                    u32x4 w; w.x = cvtpk(v0[0], v0[1]); w.y = cvtpk(v0[2], v0[3]); w.z = cvtpk(v1[0], v1[1]); w.w = cvtpk(v1[2], v1[3]);
                    *(GAS u32x4*)(rowp + bj * 128) = w; } }
    }
};
struct EpiBf {
    static constexpr bool PERM = true, AFTER_DRAIN = false;
    bf16_t* O; int ldc; int relu2; const float* ssq;
    __device__ __forceinline__ void operator()(const f32x4 (&acc)[2][2][4][2], const Unit& u, int wr, int wc, int fr, int fq) const {
        const int row0 = u.pm * 256 + wr * 64 + fr; const int col0 = u.pn * 256 + wc * 32 + 8 * fq;
#pragma unroll
        for (int ai = 0; ai < 2; ++ai)
#pragma unroll
            for (int m = 0; m < 4; ++m) { bf16_t* rowp = O + (size_t)(row0 + ai * 128 + m * 16) * ldc + col0; const float rs = rstd_of(ssq, row0 + ai * 128 + m * 16);
#pragma unroll
                for (int bj = 0; bj < 2; ++bj) { f32x4 v0 = acc[ai][bj][m][0] * rs, v1 = acc[ai][bj][m][1] * rs;
                    if (relu2) {
#pragma unroll
                        for (int e = 0; e < 4; ++e) { const float a = fmaxf(v0[e], 0.f), b = fmaxf(v1[e], 0.f); v0[e] = a * a; v1[e] = b * b; } }
                    u32x4 w; w.x = cvtpk(v0[0], v0[1]); w.y = cvtpk(v0[2], v0[3]); w.z = cvtpk(v1[0], v1[1]); w.w = cvtpk(v1[2], v1[3]);
                    if (relu2) __builtin_nontemporal_store(w, (GAS u32x4*)(rowp + bj * 128)); else *(GAS u32x4*)(rowp + bj * 128) = w; } }
    }
};
struct EpiRes {
    static constexpr bool PERM = false, AFTER_DRAIN = false;
    const float* in0; const float* in1; float* out;
    __device__ __forceinline__ void operator()(const f32x4 (&acc)[2][2][4][2], const Unit& u, int wr, int wc, int fr, int fq) const {
        const int row0 = u.pm * 256 + wr * 64 + fr; const int col0 = u.pn * 256 + wc * 32 + 4 * fq;
#pragma unroll
        for (int ai = 0; ai < 2; ++ai)
#pragma unroll
            for (int m = 0; m < 4; ++m) { const int row = row0 + ai * 128 + m * 16;
                const float* ip = (row < MP ? in0 + (size_t)row * 1024 : in1 + (size_t)(row - MP) * 1024) + col0; float* op = out + (size_t)row * 1024 + col0;
#pragma unroll
                for (int bj = 0; bj < 2; ++bj)
#pragma unroll
                    for (int n = 0; n < 2; ++n) { const f32x4 x = *(const f32x4*)(ip + bj * 128 + n * 16); *(f32x4*)(op + bj * 128 + n * 16) = x + acc[ai][bj][m][n]; }
                asm volatile("" ::: "memory"); }
    }
};
struct EpiGate {
    static constexpr bool PERM = false, AFTER_DRAIN = false;
    float* h; const bf16_t* PG;
    __device__ __forceinline__ void operator()(const f32x4 (&acc)[2][2][4][2], const Unit& u, int wr, int wc, int fr, int fq) const {
        const int row0 = u.pm * 256 + wr * 64 + fr; const int col0 = u.pn * 256 + wc * 32 + 4 * fq;
#pragma unroll
        for (int ai = 0; ai < 2; ++ai)
#pragma unroll
            for (int m = 0; m < 4; ++m) { const int row = row0 + ai * 128 + m * 16; float* hp = h + (size_t)row * 1024 + col0; const bf16_t* pp = PG + (size_t)row * 1024 + col0;
#pragma unroll
                for (int bj = 0; bj < 2; ++bj)
#pragma unroll
                    for (int n = 0; n < 2; ++n) { f32x4 x = *(const f32x4*)(hp + bj * 128 + n * 16); const u32x2 pw = *(const u32x2*)(pp + bj * 128 + n * 16); const f32x4 a = acc[ai][bj][m][n];
                        x[0] += bflo(pw.x) / (1.f + __expf(-a[0])); x[1] += bfhi(pw.x) / (1.f + __expf(-a[1]));
                        x[2] += bflo(pw.y) / (1.f + __expf(-a[2])); x[3] += bfhi(pw.y) / (1.f + __expf(-a[3]));
                        *(f32x4*)(hp + bj * 128 + n * 16) = x; }
                asm volatile("" ::: "memory"); }
    }
};


struct EpiRes2 {
    static constexpr bool PERM = true, AFTER_DRAIN = false;
    const float* inf; const bf16_t* inb; bf16_t* outb; float* ssq;
    __device__ __forceinline__ void operator()(const f32x4 (&acc)[2][2][4][2], const Unit& u, int wr, int wc, int fr, int fq) const {
        const int row0 = u.pm * 256 + wr * 64 + fr; const int col0 = u.pn * 256 + wc * 32 + 8 * fq;
#pragma unroll
        for (int ai = 0; ai < 2; ++ai)
#pragma unroll
            for (int m = 0; m < 4; ++m) { const int row = row0 + ai * 128 + m * 16; const size_t off = (size_t)row * 1024 + col0; float sq = 0.f;
#pragma unroll
                for (int bj = 0; bj < 2; ++bj) { f32x4 x0, x1;
                    if (inf) { x0 = *(const GAS f32x4*)(inf + off + bj * 128); x1 = *(const GAS f32x4*)(inf + off + bj * 128 + 4); }
                    else { const u32x4 hv = *(const GAS u32x4*)(inb + off + bj * 128); x0 = (f32x4){bflo(hv.x), bfhi(hv.x), bflo(hv.y), bfhi(hv.y)}; x1 = (f32x4){bflo(hv.z), bfhi(hv.z), bflo(hv.w), bfhi(hv.w)}; }
                    x0 = x0 + acc[ai][bj][m][0]; x1 = x1 + acc[ai][bj][m][1];
                    sq += (x0[0] * x0[0] + x0[1] * x0[1]) + (x0[2] * x0[2] + x0[3] * x0[3]) + (x1[0] * x1[0] + x1[1] * x1[1]) + (x1[2] * x1[2] + x1[3] * x1[3]);
                    u32x4 w; w.x = cvtpk(x0[0], x0[1]); w.y = cvtpk(x0[2], x0[3]); w.z = cvtpk(x1[0], x1[1]); w.w = cvtpk(x1[2], x1[3]);
                    *(GAS u32x4*)(outb + off + bj * 128) = w; }
                sq += __shfl_xor(sq, 16); sq += __shfl_xor(sq, 32);
                if (fq == 0) __hip_atomic_fetch_add(ssq + row, sq, __ATOMIC_RELAXED, __HIP_MEMORY_SCOPE_AGENT);
                if (m & 1) asm volatile("" ::: "memory"); }
    }
};
struct EpiGate2 {
    static constexpr bool PERM = true, AFTER_DRAIN = false;
    const bf16_t* hin; const bf16_t* PG; const float* ssq_in; bf16_t* hout; float* ssq_out;
    __device__ __forceinline__ void operator()(const f32x4 (&acc)[2][2][4][2], const Unit& u, int wr, int wc, int fr, int fq) const {
        const int row0 = u.pm * 256 + wr * 64 + fr; const int col0 = u.pn * 256 + wc * 32 + 8 * fq;
#pragma unroll
        for (int ai = 0; ai < 2; ++ai)
#pragma unroll
            for (int m = 0; m < 4; ++m) { const int row = row0 + ai * 128 + m * 16; const size_t off = (size_t)row * 1024 + col0;
                const float rs = -rstd_of(ssq_in, row); float sq = 0.f;
#pragma unroll
                for (int bj = 0; bj < 2; ++bj) { const u32x4 hv = *(const GAS u32x4*)(hin + off + bj * 128); const u32x4 pv = *(const GAS u32x4*)(PG + off + bj * 128);
                    const f32x4 a0 = acc[ai][bj][m][0], a1 = acc[ai][bj][m][1]; float x[8];
                    x[0] = bflo(hv.x) + bflo(pv.x) / (1.f + __expf(a0[0] * rs)); x[1] = bfhi(hv.x) + bfhi(pv.x) / (1.f + __expf(a0[1] * rs));
                    x[2] = bflo(hv.y) + bflo(pv.y) / (1.f + __expf(a0[2] * rs)); x[3] = bfhi(hv.y) + bfhi(pv.y) / (1.f + __expf(a0[3] * rs));
                    x[4] = bflo(hv.z) + bflo(pv.z) / (1.f + __expf(a1[0] * rs)); x[5] = bfhi(hv.z) + bfhi(pv.z) / (1.f + __expf(a1[1] * rs));
                    x[6] = bflo(hv.w) + bflo(pv.w) / (1.f + __expf(a1[2] * rs)); x[7] = bfhi(hv.w) + bfhi(pv.w) / (1.f + __expf(a1[3] * rs));
#pragma unroll
                    for (int e = 0; e < 8; ++e) sq += x[e] * x[e];
                    u32x4 w; w.x = cvtpk(x[0], x[1]); w.y = cvtpk(x[2], x[3]); w.z = cvtpk(x[4], x[5]); w.w = cvtpk(x[6], x[7]);
                    *(GAS u32x4*)(hout + off + bj * 128) = w; }
                sq += __shfl_xor(sq, 16); sq += __shfl_xor(sq, 32);
                if (fq == 0) __hip_atomic_fetch_add(ssq_out + row, sq, __ATOMIC_RELAXED, __HIP_MEMORY_SCOPE_AGENT);
                if (m & 1) asm volatile("" ::: "memory"); }
    }
};

__device__ __forceinline__ int ilv(int w) { return (w & 1) ? 16 + (w >> 1) : (w >> 1); }
__device__ __forceinline__ int srccol(int mode, int n) {
    if (mode == 1) {
        if (n < 640) return n;
        if (n < 672) return 640 + ilv(n - 640);
        if (n < 768) return -1;
        if (n < 1024) { const int i = n - 768; return 672 + (i & ~31) + ilv(i & 31); }
        if (n < 1280) { const int i = n - 1024; return 928 + (i & ~31) + ilv(i & 31); }
        return n - 1280 + 1184;
    }
    if (mode == 2) {
        if (n < 512) return (n >> 6) * 96 + (n & 63);
        const int i = n - 512; return (i >> 5) * 96 + 64 + ilv(i & 31);
    }
    if (mode == 3) {
        if (n < 512) return (n >> 6) * 128 + (n & 63);
        const int i = n - 512; return (i >> 6) * 128 + 64 + (i & 63);
    }
    return n;
}
__device__ __forceinline__ void wconv_item(const float* W, int K, int N, int NP, int mode, const float* scale, bf16_t* WT, LAS float* scr, int item, int lane) {
    const int nblk = NP / 32, kb = item / nblk, nb = item % nblk, k0 = 64 * kb, n0 = 32 * nb;
    const bool contig = (mode == 0) || (mode == 3) || (mode == 1 && (n0 < 640 || n0 >= 1280)) || (mode == 2 && n0 < 512);
    if (contig) {
        const int c0 = srccol(mode, n0), kr = lane >> 3, c4 = (lane & 7) * 4;
#pragma unroll
        for (int i = 0; i < 8; ++i) { const int kk = kr + 8 * i; f32x4 v = *(const GAS f32x4*)(W + (size_t)(k0 + kk) * N + c0 + c4); if (scale) v = v * scale[k0 + kk];
            scr[kk * 33 + c4] = v[0]; scr[kk * 33 + c4 + 1] = v[1]; scr[kk * 33 + c4 + 2] = v[2]; scr[kk * 33 + c4 + 3] = v[3]; }
    } else {
        const int sc = srccol(mode, n0 + (lane & 31));
#pragma unroll 8
        for (int i = 0; i < 32; ++i) { const int kk = 2 * i + (lane >> 5); float v = (sc >= 0) ? W[(size_t)(k0 + kk) * N + sc] : 0.f; if (scale) v *= scale[k0 + kk]; scr[kk * 33 + (lane & 31)] = v; }
    }
    asm volatile("s_waitcnt lgkmcnt(0)" ::: "memory");
    const int c = lane & 7;
#pragma unroll
    for (int j = 0; j < 4; ++j) { const int n = (lane >> 3) + 8 * j; const LAS float* s = scr + (8 * c) * 33 + n;
        u32x4 o; o.x = cvtpk(s[0 * 33], s[1 * 33]); o.y = cvtpk(s[2 * 33], s[3 * 33]); o.z = cvtpk(s[4 * 33], s[5 * 33]); o.w = cvtpk(s[6 * 33], s[7 * 33]);
        *(u32x4*)(WT + (size_t)(n0 + n) * K + k0 + 8 * c) = o; }
    asm volatile("s_waitcnt lgkmcnt(0)" ::: "memory");
}
__device__ __forceinline__ void norm_row_bf16(const float* xrow, bf16_t* orow, int lane) {
    const f32x4* xr = (const f32x4*)xrow + lane; f32x4 v[4]; float s = 0.f;
#pragma unroll
    for (int j = 0; j < 4; ++j) { v[j] = xr[64 * j]; s += (v[j][0] * v[j][0] + v[j][1] * v[j][1]) + (v[j][2] * v[j][2] + v[j][3] * v[j][3]); }
    const float rstd = rsqrtf(wave_sum(s) * (1.f / 1024.f) + EPS);
    u32x2* o8 = (u32x2*)orow + lane;
#pragma unroll
    for (int j = 0; j < 4; ++j) { u32x2 w; w.x = cvtpk(v[j][0] * rstd, v[j][1] * rstd); w.y = cvtpk(v[j][2] * rstd, v[j][3] * rstd); o8[64 * j] = w; }
}
__device__ __forceinline__ void final_norm_row_bf(const bf16_t* hrow, float* yrow, const float* w, int lane) {
    const u32x2* xr = (const u32x2*)hrow + lane; f32x4* yr = (f32x4*)yrow + lane; const f32x4* wr = (const f32x4*)w + lane; f32x4 v[4]; float s = 0.f;
#pragma unroll
    for (int j = 0; j < 4; ++j) { const u32x2 t = xr[64 * j]; v[j] = (f32x4){bflo(t.x), bfhi(t.x), bflo(t.y), bfhi(t.y)}; s += (v[j][0] * v[j][0] + v[j][1] * v[j][1]) + (v[j][2] * v[j][2] + v[j][3] * v[j][3]); }
    const float rstd = rsqrtf(wave_sum(s) * (1.f / 1024.f) + EPS);
#pragma unroll
    for (int j = 0; j < 4; ++j) yr[64 * j] = v[j] * rstd * wr[64 * j];
}
__device__ __forceinline__ void final_norm_row(float* hrow, const float* w, int lane) {
    f32x4* xr = (f32x4*)hrow + lane; const f32x4* wr = (const f32x4*)w + lane; f32x4 v[4]; float s = 0.f;
#pragma unroll
    for (int j = 0; j < 4; ++j) { v[j] = xr[64 * j]; s += (v[j][0] * v[j][0] + v[j][1] * v[j][1]) + (v[j][2] * v[j][2] + v[j][3] * v[j][3]); }
    const float rstd = rsqrtf(wave_sum(s) * (1.f / 1024.f) + EPS);
#pragma unroll
    for (int j = 0; j < 4; ++j) xr[64 * j] = v[j] * rstd * wr[64 * j];
}

__device__ __forceinline__ void rowpass2(const Params& P, int layer, int row, int lane) {
    unsigned char* ws = hide_ptr(P.ws);
    const bf16_t* raw = (const bf16_t*)(ws + WS_RAW) + (size_t)row * NRAW;
    const int pos = tok_pos(row);
    const bool isp = row < MP; const int srow = row - MP;
    const int krow = isp ? row : MP + (srow >> 5) * KALL + PAST + (srow & 31);
    { const unsigned* rp = (const unsigned*)(raw + 6 * lane); const unsigned a = rp[0], b = rp[1], c = rp[2];
      const float x0 = bflo(a), x1 = bfhi(a), x2 = bflo(b), x3 = bfhi(b), x4 = bflo(c), x5 = bfhi(c);
      const float ss = wave_sum(x0 * x0 + x1 * x1 + x2 * x2 + x3 * x3 + x4 * x4 + x5 * x5);
      const float rstd = rsqrtf(ss * (1.f / 384.f) + EPS);
      unsigned* op = (unsigned*)((bf16_t*)(ws + WS_QL) + (size_t)row * 384 + 6 * lane);
      op[0] = cvtpk(x0 * rstd, x1 * rstd); op[1] = cvtpk(x2 * rstd, x3 * rstd); op[2] = cvtpk(x4 * rstd, x5 * rstd); }
    { const u32x2 a = *(const u32x2*)(raw + 384 + 4 * lane);
      const float x0 = bflo(a.x), x1 = bfhi(a.x), x2 = bflo(a.y), x3 = bfhi(a.y);
      const float ss = wave_sum(x0 * x0 + x1 * x1 + x2 * x2 + x3 * x3);
      const float rstd = rsqrtf(ss * (1.f / 256.f) + EPS);
      const f32x4 w = *(const f32x4*)(P.in[11] + layer * 256 + 4 * lane);
      f32x4 o; o[0] = x0 * rstd * w[0]; o[1] = x1 * rstd * w[1]; o[2] = x2 * rstd * w[2]; o[3] = x3 * rstd * w[3];
      float* od = isp ? P.out + O_CKVP + ((size_t)layer * MP + row) * 256 : P.out + O_CKVS + ((size_t)layer * MS + srow) * 256;
      *(f32x4*)(od + 4 * lane) = o;
      u32x2 ob; ob.x = cvtpk(o[0], o[1]); ob.y = cvtpk(o[2], o[3]);
      *(u32x2*)((bf16_t*)(ws + WS_CKV) + (size_t)krow * 256 + 4 * lane) = ob; }
    const int j = lane & 15;
    const f32x2 cs = *(const f32x2*)((const float*)(ws + WS_TAB) + ((size_t)pos * 16 + j) * 2);
    { const unsigned a = *(const unsigned*)(raw + 640 + 2 * j); const float x1 = bflo(a), x2 = bfhi(a);
      const float o1 = x1 * cs[0] - x2 * cs[1], o2 = x1 * cs[1] + x2 * cs[0];
      if (lane < 16) { float* od = isp ? P.out + O_KRP + ((size_t)layer * MP + row) * 32 : P.out + O_KRS + ((size_t)layer * MS + srow) * 32; od[j] = o1; od[16 + j] = o2; }
      if (lane < 16) *(unsigned*)((bf16_t*)(ws + WS_KRB) + (size_t)krow * 32 + 2 * j) = cvtpk(o1, o2); }
    const int n = isp ? (row & 63) : (srow & 31);
#pragma unroll
    for (int t = 0; t < 2; ++t) { const int pi = lane + 64 * t, hh = pi >> 4; const float lgh = lg_of(hh);
        const float fq = __builtin_amdgcn_exp2f((float)n * lgh), fk = RK_SCALE * __builtin_amdgcn_exp2f(-(float)n * lgh);
        { const unsigned a = *(const unsigned*)(raw + 768 + 2 * pi); const float x1 = bflo(a), x2 = bfhi(a);
          *(unsigned*)((bf16_t*)(ws + WS_RQ) + (size_t)row * 256 + 2 * pi) = cvtpk((x1 * cs[0] - x2 * cs[1]) * fq, (x1 * cs[1] + x2 * cs[0]) * fq); }
        { const unsigned a = *(const unsigned*)(raw + 1024 + 2 * pi); const float x1 = bflo(a), x2 = bfhi(a);
          *(unsigned*)((bf16_t*)(ws + WS_RK) + (size_t)row * 256 + 2 * pi) = cvtpk((x1 * cs[0] - x2 * cs[1]) * fk, (x1 * cs[1] + x2 * cs[0]) * fk); }
    }
}
__device__ __forceinline__ void cache_row(const Params& P, int layer, int cr, int lane) {
    unsigned char* ws = hide_ptr(P.ws); const int b = cr >> 11, k = cr & (PAST - 1); const int krow = MP + b * KALL + k;
    const f32x4 v = *(const f32x4*)(P.in[2] + ((size_t)(layer * NDB + b) * PAST + k) * 256 + 4 * lane);
    u32x2 ob; ob.x = cvtpk(v[0], v[1]); ob.y = cvtpk(v[2], v[3]);
    *(u32x2*)((bf16_t*)(ws + WS_CKV) + (size_t)krow * 256 + 4 * lane) = ob;
    if (lane < 16) { const float* kr = P.in[3] + ((size_t)(layer * NDB + b) * PAST + k) * 32;
        *(unsigned*)((bf16_t*)(ws + WS_KRB) + (size_t)krow * 32 + 2 * lane) = cvtpk(kr[lane], kr[16 + lane]); }
}


struct MiniArgs { const bf16_t* A; const bf16_t* Bt; int N, K, mode; const float* inf; const bf16_t* inb; bf16_t* outb; float* ssq_out; const float* ssq_in; bf16_t* U; const bf16_t* PG; int row0; bf16_t* O2; };
__device__ __forceinline__ void mini_gemm(const MiniArgs& a, LAS unsigned char* lds, int G) {
    int tid_h = threadIdx.x; asm volatile("" : "+v"(tid_h));
    const int tid = tid_h, lane = tid & 63, r = lane & 31, h = lane >> 5; const int w = __builtin_amdgcn_readfirstlane(tid >> 6);
    const int ntile = (MS / 32) * (a.N / 32), ks = a.K >> 3;
    for (int tile = blockIdx.x; tile < ntile; tile += G) {
        const int tm = tile & 7, tn = tile >> 3;
        const int rbase = (a.row0 ? a.row0 : MP) + 32 * tm;
        const bf16_t* ap = a.A + (size_t)(rbase + r) * a.K + w * ks + 8 * h; const bf16_t* bp = a.Bt + (size_t)(32 * tn + r) * a.K + w * ks + 8 * h;
        f32x16 acc;
#pragma unroll
        for (int i = 0; i < 16; ++i) acc[i] = 0.f;
        const int nst = ks >> 4;
        for (int s0 = 0; s0 < nst; s0 += 8) {
            bf16x8 av[8], bv[8];
#pragma unroll
            for (int u = 0; u < 8; ++u) if (s0 + u < nst) { av[u] = *(const GAS bf16x8*)(ap + 16 * (s0 + u)); bv[u] = *(const GAS bf16x8*)(bp + 16 * (s0 + u)); }
#pragma unroll
            for (int u = 0; u < 8; ++u) if (s0 + u < nst) acc = MFMA32(av[u], bv[u], acc);
        }
        LAS float* red = (LAS float*)lds + w * 1024;
#pragma unroll
        for (int i = 0; i < 16; ++i) red[crow(i, h) * 32 + r] = acc[i];
        __syncthreads();
#pragma unroll
        for (int half = 0; half < 2; ++half) { const int e = tid + 512 * half; float v = 0.f;
#pragma unroll
            for (int ww = 0; ww < 8; ++ww) v += ((LAS const float*)lds)[ww * 1024 + e];
            const int row = rbase + (e >> 5), col = 32 * tn + (e & 31);
            if (a.mode == 3) { a.U[(size_t)row * 1024 + col] = (bf16_t)(cvtpk(v, 0.f) & 0xffffu); }
            else if (a.mode == 4) { bf16_t* dst = col < 512 ? a.U + (size_t)row * 512 + col : a.O2 + (size_t)row * 512 + (col - 512); *dst = (bf16_t)(cvtpk(v, 0.f) & 0xffffu); }
            else if (a.mode == 1) { const float x = fmaxf(v * rstd_of(a.ssq_in, row), 0.f); a.U[(size_t)row * a.N + col] = (bf16_t)(cvtpk(x * x, 0.f) & 0xffffu); }
            else { float x; const size_t off = (size_t)row * 1024 + col;
                if (a.mode == 0) x = (a.inf ? a.inf[(size_t)(row - MP) * 1024 + col] : __uint_as_float((unsigned)a.inb[off] << 16)) + v;
                else x = __uint_as_float((unsigned)a.inb[off] << 16) + __uint_as_float((unsigned)a.PG[off] << 16) / (1.f + __expf(-v * rstd_of(a.ssq_in, row)));
                a.outb[off] = (bf16_t)(cvtpk(x, 0.f) & 0xffffu);
                float sq = x * x;
#pragma unroll
                for (int o = 1; o < 32; o <<= 1) sq += __shfl_xor(sq, o);
                if ((lane & 31) == 0) __hip_atomic_fetch_add(a.ssq_out + row, sq, __ATOMIC_RELAXED, __HIP_MEMORY_SCOPE_AGENT); }
        }
        __syncthreads();
    }
}

namespace att {
constexpr int SUBB = 10752, VOFF = 6656;
template <int NSUBT> struct Stage { u32x4 k[(NSUBT * 32 * 12 + 511) / 512]; u32x4 v[(NSUBT * 32 * 8 + 511) / 512]; };
template <int NSUBT> __device__ __forceinline__ void tile_load(Stage<NSUBT>& st, const bf16_t* Kn, const bf16_t* Kr, const bf16_t* Vg, int nvalid, int tid) {
    constexpr int NK = (NSUBT * 32 * 12 + 511) / 512, NV = (NSUBT * 32 * 8 + 511) / 512;
#pragma unroll
    for (int i = 0; i < NK; ++i) { const int c = tid + 512 * i; const int key = c / 12, ch = c - key * 12; u32x4 v = {0u, 0u, 0u, 0u};
        if (c < NSUBT * 32 * 12 && key < nvalid) { const bf16_t* src = (ch < 8) ? Kn + (size_t)key * 512 + ch * 8 : Kr + (size_t)key * 32 + (ch - 8) * 8; v = *(const GAS u32x4*)src; }
        st.k[i] = v; }
#pragma unroll
    for (int i = 0; i < NV; ++i) { const int c = tid + 512 * i; const int key = c >> 3, ch = c & 7; u32x4 v = {0u, 0u, 0u, 0u};
        if (c < NSUBT * 32 * 8 && key < nvalid) v = *(const GAS u32x4*)(Vg + (size_t)key * 512 + ch * 8);
        st.v[i] = v; }
}
template <int NSUBT> __device__ __forceinline__ void tile_store(const Stage<NSUBT>& st, LAS unsigned char* buf, int tid) {
    constexpr int NK = (NSUBT * 32 * 12 + 511) / 512, NV = (NSUBT * 32 * 8 + 511) / 512;
#pragma unroll
    for (int i = 0; i < NK; ++i) { const int c = tid + 512 * i; const int key = c / 12, ch = c - key * 12;
        if (c < NSUBT * 32 * 12) *(LAS u32x4*)(buf + (key >> 5) * SUBB + (key & 31) * 208 + ch * 16) = st.k[i]; }
#pragma unroll
    for (int i = 0; i < NV; ++i) { const int c = tid + 512 * i; const int key = c >> 3, ch = c & 7;
        if (c < NSUBT * 32 * 8) *(LAS u32x4*)(buf + (key >> 5) * SUBB + VOFF + (ch >> 2) * 2048 + (key & 31) * 64 + (ch & 3) * 16) = st.v[i]; }
}

__device__ __forceinline__ void ptile_load(Stage<2>& st, const bf16_t* Kn, const bf16_t* Kr, const bf16_t* Vg, int tid) {
#pragma unroll
    for (int i = 0; i < 2; ++i) { const int c = (i == 1 && tid >= 256) ? tid : tid + 512 * i; const int key = c / 12, ch = c - key * 12;
        const bf16_t* src = (ch < 8) ? Kn + (size_t)key * 512 + ch * 8 : Kr + (size_t)key * 32 + (ch - 8) * 8; st.k[i] = *(const GAS u32x4*)src; }
    { const int key = tid >> 3, ch = tid & 7; st.v[0] = *(const GAS u32x4*)(Vg + (size_t)key * 512 + ch * 8); }
}
__device__ __forceinline__ void ptile_store(const Stage<2>& st, LAS unsigned char* buf, int tid) {
#pragma unroll
    for (int i = 0; i < 2; ++i) { const int c = (i == 1 && tid >= 256) ? tid : tid + 512 * i; const int key = c / 12, ch = c - key * 12;
        *(LAS u32x4*)(buf + (key >> 5) * SUBB + (key & 31) * 208 + ch * 16) = st.k[i]; }
    { const int key = tid >> 3, ch = tid & 7; *(LAS u32x4*)(buf + (key >> 5) * SUBB + VOFF + (ch >> 2) * 2048 + (key & 31) * 64 + (ch & 3) * 16) = st.v[0]; }
}
template <int NS> __device__ __forceinline__ void att_tile(LAS const unsigned char* sb, const bf16x8 (&qf)[6], float& m, float& l, f32x16 (&o)[2], int lane) {
    const int r = lane & 31, h = lane >> 5;
    const int g = (lane >> 4) & 1, q = (lane & 15) >> 2, pp = lane & 3;
    f32x16 p[NS];
#pragma unroll
    for (int kb = 0; kb < NS; ++kb)
#pragma unroll
        for (int i = 0; i < 16; ++i) p[kb][i] = 0.f;
    LAS const unsigned char* kp = sb + r * 208 + h * 16;
    lds_cptr vp = (lds_cptr)(sb + VOFF + (4 * h + q) * 64 + g * 32 + pp * 8);
    bf16x8 kf[6][NS];
#pragma unroll
    for (int j = 0; j < 6; ++j)
#pragma unroll
        for (int kb = 0; kb < NS; ++kb) kf[j][kb] = *(LAS const bf16x8*)(kp + kb * SUBB + j * 32);
    __builtin_amdgcn_sched_barrier(0);
#pragma unroll
    for (int j = 0; j < 6; ++j)
#pragma unroll
        for (int kb = 0; kb < NS; ++kb) p[kb] = MFMA32(kf[j][kb], qf[j], p[kb]);
    __builtin_amdgcn_sched_barrier(0);
    bf16x8 vf[2][2];
#pragma unroll
    for (int s = 0; s < 2; ++s)
#pragma unroll
        for (int dvh = 0; dvh < 2; ++dvh) { lds_cptr vb = vp + dvh * 2048 + 16 * s * 64; vf[s][dvh] = cat8(vtr(vb), vtr(vb + 8 * 64)); }
    __builtin_amdgcn_sched_barrier(0);
    float mx = p[0][0];
#pragma unroll
    for (int kb = 0; kb < NS; ++kb)
#pragma unroll
        for (int i = 0; i < 16; ++i) mx = fmaxf(mx, p[kb][i]);
    mx = fmaxf(mx, __shfl_xor(mx, 32));
    if (__any(mx > m + 8.f)) {
        const float mn = fmaxf(m, mx); const float alpha = __builtin_amdgcn_exp2f(m - mn); m = mn; l *= alpha;
#pragma unroll
        for (int i = 0; i < 16; ++i) { o[0][i] *= alpha; o[1][i] *= alpha; }
    }
    float sum = 0.f;
#pragma unroll
    for (int kb = 0; kb < NS; ++kb)
#pragma unroll
        for (int i = 0; i < 16; ++i) { p[kb][i] = __builtin_amdgcn_exp2f(p[kb][i] - m); sum += p[kb][i]; }
    l += sum;
#pragma unroll
    for (int kb = 0; kb < NS; ++kb) {
        const bf16x8 pf0 = pack8(p[kb], 0), pf1 = pack8(p[kb], 1);
        __builtin_amdgcn_sched_barrier(0);
        o[0] = MFMA32(vf[0][0], pf0, o[0]); o[1] = MFMA32(vf[0][1], pf0, o[1]);
        o[0] = MFMA32(vf[1][0], pf1, o[0]); o[1] = MFMA32(vf[1][1], pf1, o[1]);
        __builtin_amdgcn_sched_barrier(0);
        if (kb + 1 < NS) {
#pragma unroll
            for (int s = 0; s < 2; ++s)
#pragma unroll
                for (int dvh = 0; dvh < 2; ++dvh) { lds_cptr vb = vp + (kb + 1) * SUBB + dvh * 2048 + 16 * s * 64; vf[s][dvh] = cat8(vtr(vb), vtr(vb + 8 * 64)); }
        }
    }
}
__device__ __forceinline__ void store_o(bf16_t* dst  , const f32x16 (&o)[2], float inv, int hh) {
#pragma unroll
    for (int dvh = 0; dvh < 2; ++dvh)
#pragma unroll
        for (int g4 = 0; g4 < 4; ++g4) { u32x2 w; w.x = cvtpk(o[dvh][4 * g4] * inv, o[dvh][4 * g4 + 1] * inv); w.y = cvtpk(o[dvh][4 * g4 + 2] * inv, o[dvh][4 * g4 + 3] * inv);
            *(GAS u32x2*)(dst + 32 * dvh + 8 * g4 + 4 * hh) = w; }
}
#define ATT_SBAR() __builtin_amdgcn_sched_barrier(0)
template <bool NEXT> __device__ __forceinline__ void att_step(LAS const unsigned char* sbc, LAS const unsigned char* sbn, const bf16x8 (&qf)[6], f32x16& pc0, f32x16& pc1,
                                                               float& m, float& l, f32x16 (&o)[2], int lane) {
    const int r = lane & 31, h = lane >> 5;
    f32x16 pn0, pn1;
#pragma unroll
    for (int i = 0; i < 16; ++i) { pn0[i] = 0.f; pn1[i] = 0.f; }
    LAS const unsigned char* kp = sbn + r * 208 + h * 16;
#define ATT_QK(ks) do { if (NEXT) { const bf16x8 k0_ = *(LAS const bf16x8*)(kp + (ks) * 32), k1_ = *(LAS const bf16x8*)(kp + SUBB + (ks) * 32); \
        pn0 = MFMA32(k0_, qf[ks], pn0); pn1 = MFMA32(k1_, qf[ks], pn1); } } while (0)
    ATT_QK(0);
    float mxa = fmaxf(fmaxf(pc0[0], pc0[1]), fmaxf(pc0[2], pc0[3])); mxa = fmaxf(mxa, fmaxf(fmaxf(pc0[4], pc0[5]), fmaxf(pc0[6], pc0[7])));
    ATT_SBAR(); ATT_QK(1);
    float mxb = fmaxf(fmaxf(pc0[8], pc0[9]), fmaxf(pc0[10], pc0[11])); mxb = fmaxf(mxb, fmaxf(fmaxf(pc0[12], pc0[13]), fmaxf(pc0[14], pc0[15])));
    ATT_SBAR(); ATT_QK(2);
    float mxc = fmaxf(fmaxf(pc1[0], pc1[1]), fmaxf(pc1[2], pc1[3])); mxc = fmaxf(mxc, fmaxf(fmaxf(pc1[4], pc1[5]), fmaxf(pc1[6], pc1[7])));
    float mxd = fmaxf(fmaxf(pc1[8], pc1[9]), fmaxf(pc1[10], pc1[11])); mxd = fmaxf(mxd, fmaxf(fmaxf(pc1[12], pc1[13]), fmaxf(pc1[14], pc1[15])));
    float mx = fmaxf(fmaxf(mxa, mxb), fmaxf(mxc, mxd)); mx = fmaxf(mx, __shfl_xor(mx, 32));
    ATT_SBAR();
    if (__any(mx > m + 8.f)) {
        const float mn = fmaxf(m, mx); const float alpha = __builtin_amdgcn_exp2f(m - mn); m = mn; l *= alpha;
#pragma unroll
        for (int i = 0; i < 16; ++i) { o[0][i] *= alpha; o[1][i] *= alpha; }
    }
    float sum = 0.f;
    ATT_QK(3);
#pragma unroll
    for (int i = 0; i < 8; ++i) { pc0[i] = __builtin_amdgcn_exp2f(pc0[i] - m); sum += pc0[i]; }
    ATT_SBAR(); ATT_QK(4);
#pragma unroll
    for (int i = 8; i < 16; ++i) { pc0[i] = __builtin_amdgcn_exp2f(pc0[i] - m); sum += pc0[i]; }
    ATT_SBAR(); ATT_QK(5);
#pragma unroll
    for (int i = 0; i < 8; ++i) { pc1[i] = __builtin_amdgcn_exp2f(pc1[i] - m); sum += pc1[i]; }
    ATT_SBAR();
#pragma unroll
    for (int i = 8; i < 16; ++i) { pc1[i] = __builtin_amdgcn_exp2f(pc1[i] - m); sum += pc1[i]; }
    l += sum;
    const int g = (lane >> 4) & 1, q = (lane & 15) >> 2, pp = lane & 3;
#pragma unroll
    for (int kb = 0; kb < 2; ++kb)
#pragma unroll
        for (int s_ = 0; s_ < 2; ++s_) { const bf16x8 pf = pack8(kb == 0 ? pc0 : pc1, s_);
#pragma unroll
            for (int dvh = 0; dvh < 2; ++dvh) { lds_cptr vb = (lds_cptr)(sbc + kb * SUBB + VOFF + dvh * 2048 + (16 * s_ + 4 * h + q) * 64 + g * 32 + pp * 8);
                const bf16x8 vf = cat8(vtr(vb), vtr(vb + 8 * 64)); o[dvh] = MFMA32(vf, pf, o[dvh]); } }
    if (NEXT) { pc0 = pn0; pc1 = pn1; }
#undef ATT_QK
}
__device__ __forceinline__ void prompt_unit(int b, int h, int qb, const bf16_t* Q, const bf16_t* KN, const bf16_t* KRB, const bf16_t* V, bf16_t* MIX, LAS unsigned char* lds) {
    int tid_h = threadIdx.x; asm volatile("" : "+v"(tid_h));
    const int tid = tid_h, lane = tid & 63, r = lane & 31, hh = lane >> 5; const int w = __builtin_amdgcn_readfirstlane(tid >> 6);
    const size_t qrow = (size_t)b * SEQ + qb * 256 + w * 32 + r;
    bf16x8 qf[6];
#pragma unroll
    for (int ks = 0; ks < 6; ++ks) qf[ks] = *(const GAS bf16x8*)(Q + qrow * 768 + h * 96 + ks * 16 + hh * 8);
    const int NT = 4 * qb + 4, myNT = 4 * qb + (w >> 1) + 1;
    const bf16_t* Kn0 = KN + (size_t)b * SEQ * 512 + h * 64; const bf16_t* Kr0 = KRB + (size_t)b * SEQ * 32; const bf16_t* V0 = V + (size_t)b * SEQ * 512 + h * 64;
    float m = -INFINITY, l = 0.f; f32x16 o[2];
#pragma unroll
    for (int i = 0; i < 16; ++i) { o[0][i] = 0.f; o[1][i] = 0.f; }
    Stage<2> st;
    ptile_load(st, Kn0, Kr0, V0, tid); ptile_store(st, lds, tid);
    ptile_load(st, Kn0 + (size_t)64 * 512, Kr0 + (size_t)64 * 32, V0 + (size_t)64 * 512, tid); ptile_store(st, lds + 2 * SUBB, tid);
    __syncthreads();
    int bc = 0, bn = 2 * SUBB, bnn = 4 * SUBB;
    Stage<2> st2;
#define ATT_LOAD(S_, tt) ptile_load(S_, Kn0 + (size_t)(tt) * 64 * 512, Kr0 + (size_t)(tt) * 64 * 32, V0 + (size_t)(tt) * 64 * 512, tid)
#define ATT_COMPUTE(tt) do { if ((tt) < myNT) att_tile<2>(lds + bc, qf, m, l, o, lane); } while (0)
#define ATT_ROT() do { const int tmp_ = bc; bc = bn; bn = bnn; bnn = tmp_; } while (0)
    ATT_LOAD(st, 2);
    for (int t = 0; t < NT; t += 2) {
        if (t + 3 < NT) ATT_LOAD(st2, t + 3);
        ATT_COMPUTE(t);
        if (t + 2 < NT) ptile_store(st, lds + bnn, tid);
        asm volatile("s_waitcnt lgkmcnt(0)\n\ts_barrier" ::: "memory"); ATT_ROT();
        if (t + 4 < NT) ATT_LOAD(st, t + 4);
        ATT_COMPUTE(t + 1);
        if (t + 3 < NT) ptile_store(st2, lds + bnn, tid);
        asm volatile("s_waitcnt lgkmcnt(0)\n\ts_barrier" ::: "memory"); ATT_ROT();
    }
#undef ATT_LOAD
#undef ATT_COMPUTE
#undef ATT_ROT
    l += __shfl_xor(l, 32);
    store_o(MIX + qrow * 1024 + h * 64, o, 1.f / l, hh);
}
__device__ __forceinline__ void sample_unit(int b, int h, const bf16_t* Q, const bf16_t* KN, const bf16_t* KRB, const bf16_t* V, bf16_t* MIX, LAS unsigned char* lds) {
    int tid_h = threadIdx.x; asm volatile("" : "+v"(tid_h));
    const int tid = tid_h, lane = tid & 63, r = lane & 31, hh = lane >> 5; const int w = __builtin_amdgcn_readfirstlane(tid >> 6);
    const size_t qrow = (size_t)MP + b * LDEC + r;
    bf16x8 qf[6];
#pragma unroll
    for (int ks = 0; ks < 6; ++ks) qf[ks] = *(const GAS bf16x8*)(Q + qrow * 768 + h * 96 + ks * 16 + hh * 8);
    const size_t kr0 = (size_t)MP + (size_t)b * KALL;
    const bf16_t* Kn0 = KN + kr0 * 512 + h * 64; const bf16_t* Kr0 = KRB + kr0 * 32; const bf16_t* V0 = V + kr0 * 512 + h * 64;
    float m = -INFINITY, l = 0.f; f32x16 o[2];
#pragma unroll
    for (int i = 0; i < 16; ++i) { o[0][i] = 0.f; o[1][i] = 0.f; }
    for (int st_ = 0; st_ < 9; ++st_) { const int nvalid = (KALL - 256 * st_) < 256 ? (KALL - 256 * st_) : 256;
#pragma unroll 1
        for (int rd = 0; rd < 2; ++rd) { Stage<4> sg; const size_t k0 = (size_t)st_ * 256 + rd * 128;
            tile_load<4>(sg, Kn0 + k0 * 512, Kr0 + k0 * 32, V0 + k0 * 512, nvalid - rd * 128, tid); tile_store<4>(sg, lds + rd * 4 * SUBB, tid); }
        __syncthreads();
        if (w * 32 < nvalid) att_tile<1>(lds + w * SUBB, qf, m, l, o, lane);
        __syncthreads();
    }
    l += __shfl_xor(l, 32);
    LAS float* Ow = (LAS float*)(lds + w * 8192); LAS float* Mw = (LAS float*)(lds + 65536); LAS float* Lw = (LAS float*)(lds + 65536 + 1024);
#pragma unroll
    for (int dvh = 0; dvh < 2; ++dvh)
#pragma unroll
        for (int i = 0; i < 16; ++i) Ow[(32 * dvh + crow(i, hh)) * 32 + r] = o[dvh][i];
    if (hh == 0) { Mw[w * 32 + r] = m; Lw[w * 32 + r] = l; }
    __syncthreads();
    { const int q = tid & 31, dv0 = 4 * (tid >> 5); float ms = -INFINITY;
#pragma unroll
      for (int ww = 0; ww < 8; ++ww) ms = fmaxf(ms, Mw[ww * 32 + q]);
      float den = 0.f, a0 = 0.f, a1 = 0.f, a2 = 0.f, a3 = 0.f;
#pragma unroll
      for (int ww = 0; ww < 8; ++ww) { const float f = __builtin_amdgcn_exp2f(Mw[ww * 32 + q] - ms); den += f * Lw[ww * 32 + q]; const LAS float* op = (const LAS float*)(lds + ww * 8192) + dv0 * 32 + q;
          a0 += f * op[0]; a1 += f * op[32]; a2 += f * op[64]; a3 += f * op[96]; }
      const float inv = 1.f / den; u32x2 wv; wv.x = cvtpk(a0 * inv, a1 * inv); wv.y = cvtpk(a2 * inv, a3 * inv);
      *(u32x2*)(MIX + ((size_t)MP + b * LDEC + q) * 1024 + h * 64 + dv0) = wv; }
    __syncthreads();
}
}

struct RetItem { int b, h, row0, L; };
__device__ __forceinline__ RetItem ret_decode(int item) {
    RetItem it;
    if (item < NITEM_P) { it.b = item >> 10; it.h = (item >> 7) & 7; it.row0 = it.b * SEQ + (item & 127) * 64; it.L = 64; }
    else { const int j = item - NITEM_P; it.b = j >> 3; it.h = j & 7; it.row0 = MP + it.b * LDEC; it.L = 32; }
    return it;
}
__device__ __forceinline__ void ret_stage_v(const bf16_t* RVG, const RetItem& it, LAS unsigned char* img, int lane) {
#pragma unroll
    for (int i = 0; i < 8; ++i) { const int c = lane + 64 * i, tok = c >> 3, ch = c & 7; u32x4 v = {0u, 0u, 0u, 0u};
        if (tok < it.L) v = *(const GAS u32x4*)(RVG + (size_t)(it.row0 + tok) * 1024 + it.h * 64 + ch * 8);
        *(LAS u32x4*)(img + (ch >> 2) * 4096 + tok * 64 + (ch & 3) * 16) = v; }
}
__device__ __forceinline__ void ret_kv_item(int item, const bf16_t* RK, const bf16_t* RVG, float* KVt, LAS unsigned char* lw, int lane) {
    const RetItem it = ret_decode(item); const int r = lane & 31, h = lane >> 5, g = (lane >> 4) & 1, q = (lane & 15) >> 2, pp = lane & 3;
    ret_stage_v(RVG, it, lw, lane);
#pragma unroll
    for (int i = 0; i < 4; ++i) { const int c = lane + 64 * i, tok = c >> 2, ch = c & 3; u32x4 v = {0u, 0u, 0u, 0u};
        if (tok < it.L) v = *(const GAS u32x4*)(RK + (size_t)(it.row0 + tok) * 256 + it.h * 32 + ch * 8);
        *(LAS u32x4*)(lw + 8192 + tok * 64 + ch * 16) = v; }
    f32x16 a0, a1;
#pragma unroll
    for (int i = 0; i < 16; ++i) { a0[i] = 0.f; a1[i] = 0.f; }
    const int ns = it.L >> 4;
#pragma unroll
    for (int s = 0; s < 4; ++s) if (s < ns) {
        const int off = (16 * s + 8 * h + q) * 64 + g * 32 + pp * 8;
        const bf16x8 v0 = cat8(vtr((lds_cptr)(lw + off)), vtr((lds_cptr)(lw + off + 4 * 64)));
        const bf16x8 v1 = cat8(vtr((lds_cptr)(lw + 4096 + off)), vtr((lds_cptr)(lw + 4096 + off + 4 * 64)));
        const bf16x8 kk = cat8(vtr((lds_cptr)(lw + 8192 + off)), vtr((lds_cptr)(lw + 8192 + off + 4 * 64)));
        a0 = MFMA32(v0, kk, a0); a1 = MFMA32(v1, kk, a1);
    }
    float* dst = KVt + (size_t)item * 2048;
#pragma unroll
    for (int i = 0; i < 16; ++i) { ((GAS float*)dst)[crow(i, h) * 32 + r] = a0[i]; ((GAS float*)dst)[(32 + crow(i, h)) * 32 + r] = a1[i]; }
}
__device__ __forceinline__ void ret_scan_prompt(const Params& P, int layer, int idx) {
    const int bh = idx >> 11, e = idx & 2047; const float lgh = lg_of(bh & 7);
    const float g1 = exp2f(lgh), g63 = exp2f(63.f * lgh), g64 = exp2f(64.f * lgh);
    unsigned char* wsh = hide_ptr(P.ws);
    const float* kv = (const float*)(wsh + WS_KVT) + (size_t)bh * 128 * 2048 + e; bf16_t* st = (bf16_t*)(wsh + WS_ST) + (size_t)bh * 128 * 2048 + e;
    float S = 0.f;
#pragma unroll 32
    for (int c = 0; c < 128; ++c) { const float k = kv[(size_t)c * 2048]; st[(size_t)c * 2048] = (bf16_t)(cvtpk(g1 * S, 0.f) & 0xffffu); S = g64 * S + g63 * k; }
    P.out[O_RETP + (((size_t)layer * 32 + bh) * 32 + ilv(e & 31)) * 64 + (e >> 5)] = S;
}
__device__ __forceinline__ void ret_scan_sample(const Params& P, int layer, int idx) {
    const int j = idx >> 11, e = idx & 2047; const float lgh = lg_of(j & 7);
    const float g1 = exp2f(lgh), g31 = exp2f(31.f * lgh), g32 = exp2f(32.f * lgh);
    const size_t so = (((size_t)layer * 64 + j) * 32 + ilv(e & 31)) * 64 + (e >> 5);
    unsigned char* wsh = hide_ptr(P.ws);
    const float Sin = P.in[4][so]; const float k = ((const float*)(wsh + WS_KVT))[(size_t)(NITEM_P + j) * 2048 + e];
    ((bf16_t*)(wsh + WS_ST))[(size_t)(NITEM_P + j) * 2048 + e] = (bf16_t)(cvtpk(g1 * Sin, 0.f) & 0xffffu);
    P.out[O_RETS + so] = g32 * Sin + g31 * k;
}
__device__ __forceinline__ void ret_out_item(const Params& P, int layer, int item, LAS unsigned char* lw, int lane) {
    const RetItem it = ret_decode(item); const int r = lane & 31, h = lane >> 5, g = (lane >> 4) & 1, q = (lane & 15) >> 2, pp = lane & 3;
    unsigned char* wsh = hide_ptr(P.ws);
    const bf16_t* RQ = (const bf16_t*)(wsh + WS_RQ); const bf16_t* RK = (const bf16_t*)(wsh + WS_RK); const bf16_t* RVG = (const bf16_t*)(wsh + WS_RVG);
    const bf16_t* St = (const bf16_t*)(wsh + WS_ST) + (size_t)item * 2048; bf16_t* MIX = (bf16_t*)(wsh + WS_MIX);
    const int NH = it.L >> 5;
    ret_stage_v(RVG, it, lw, lane);
    bf16x8 ka[2][2], qb[2][2], sa[2][2];
#pragma unroll
    for (int x = 0; x < 2; ++x)
#pragma unroll
        for (int s = 0; s < 2; ++s) {
            const int tr = (x < NH) ? it.row0 + 32 * x + r : it.row0 + r;
            ka[x][s] = *(const GAS bf16x8*)(RK + (size_t)tr * 256 + it.h * 32 + 16 * s + 8 * h);
            qb[x][s] = *(const GAS bf16x8*)(RQ + (size_t)tr * 256 + it.h * 32 + 16 * s + 8 * h);
            sa[x][s] = *(const GAS bf16x8*)(St + (32 * x + r) * 32 + 16 * s + 8 * h);
        }
    f32x16 o[2][2];
#pragma unroll
    for (int nh = 0; nh < 2; ++nh) if (nh < NH) {
#pragma unroll
        for (int dvh = 0; dvh < 2; ++dvh) {
#pragma unroll
            for (int i = 0; i < 16; ++i) o[dvh][nh][i] = 0.f;
            o[dvh][nh] = MFMA32(sa[dvh][0], qb[nh][0], o[dvh][nh]); o[dvh][nh] = MFMA32(sa[dvh][1], qb[nh][1], o[dvh][nh]);
        }
#pragma unroll
        for (int mh = 0; mh < 2; ++mh) if (mh <= nh) {
            f32x16 T;
#pragma unroll
            for (int i = 0; i < 16; ++i) T[i] = 0.f;
            T = MFMA32(ka[mh][0], qb[nh][0], T); T = MFMA32(ka[mh][1], qb[nh][1], T);
            if (mh == nh) {
#pragma unroll
                for (int i = 0; i < 16; ++i) if (crow(i, h) > r) T[i] = 0.f;
            }
#pragma unroll
            for (int s = 0; s < 2; ++s) { const bf16x8 pf = pack8(T, s);
#pragma unroll
                for (int dvh = 0; dvh < 2; ++dvh) { lds_cptr vb = (lds_cptr)(lw + dvh * 4096 + (32 * mh + 16 * s + 4 * h + q) * 64 + g * 32 + pp * 8);
                    const bf16x8 vf = cat8(vtr(vb), vtr(vb + 8 * 64)); o[dvh][nh] = MFMA32(vf, pf, o[dvh][nh]); } }
        }
        float sum = 0.f;
#pragma unroll
        for (int dvh = 0; dvh < 2; ++dvh)
#pragma unroll
            for (int i = 0; i < 16; ++i) sum += o[dvh][nh][i];
        sum += __shfl_xor(sum, 32); const float mu = sum * (1.f / 64.f);
        float var = 0.f;
#pragma unroll
        for (int dvh = 0; dvh < 2; ++dvh)
#pragma unroll
            for (int i = 0; i < 16; ++i) { const float d = o[dvh][nh][i] - mu; var += d * d; }
        var += __shfl_xor(var, 32); const float rstd = rsqrtf(var * (1.f / 64.f) + EPS);
        const size_t row = (size_t)it.row0 + 32 * nh + r;
#pragma unroll
        for (int dvh = 0; dvh < 2; ++dvh)
#pragma unroll
            for (int g4 = 0; g4 < 4; ++g4) { const int dv0 = 32 * dvh + 8 * g4 + 4 * h;
                const f32x4 gw = *(const GAS f32x4*)(P.in[13] + layer * 512 + it.h * 64 + dv0);
                const u32x2 gg = *(const GAS u32x2*)(RVG + row * 1024 + 512 + it.h * 64 + dv0);
                float gv[4] = {bflo(gg.x), bfhi(gg.x), bflo(gg.y), bfhi(gg.y)}; float ov[4];
#pragma unroll
                for (int e = 0; e < 4; ++e) { const float sg = gv[e] / (1.f + __expf(-gv[e])); ov[e] = (o[dvh][nh][4 * g4 + e] - mu) * rstd * gw[e] * sg; }
                u32x2 wv; wv.x = cvtpk(ov[0], ov[1]); wv.y = cvtpk(ov[2], ov[3]);
                *(GAS u32x2*)(MIX + row * 1024 + 512 + it.h * 64 + dv0) = wv; }
    }
}


#ifdef SELFCHK
constexpr size_t WS_DBG = 55 * MiB;
__device__ __forceinline__ float bf2f(bf16_t v) { return __uint_as_float((unsigned)v << 16); }
__device__ __forceinline__ void chk_acc(float* acc, int k, float got, float ref) { atomicAdd(acc + 2 * k, (got - ref) * (got - ref)); atomicAdd(acc + 2 * k + 1, ref * ref); }
__device__ __forceinline__ unsigned hsh(unsigned x) { x ^= x >> 16; x *= 0x7feb352dU; x ^= x >> 15; x *= 0x846ca68bU; x ^= x >> 16; return x; }
__device__ __forceinline__ int samp_row(unsigned i) { const unsigned r = hsh(i * 2654435761u + 12345u); return (i & 3) == 3 ? MP + (int)(r % MS) : (int)(r % MP); }
__device__ __forceinline__ void chk_after_ph3(const Params& P, int gtid) {
    unsigned char* ws = P.ws; float* acc = (float*)(ws + WS_DBG);
    if (gtid < 256) {
        const int row = samp_row(gtid); const unsigned r2 = hsh(gtid + 777u); const int h = r2 & 7, j = (r2 >> 3) & 15, dv = (r2 >> 7) & 63;
        const float* x = row < MP ? P.in[0] + (size_t)row * 1024 : P.in[1] + (size_t)(row - MP) * 1024;
        float ss = 0.f; for (int k = 0; k < 1024; ++k) ss += x[k] * x[k];
        const float rstd = rsqrtf(ss / 1024.f + EPS);
        float p1 = 0.f, p2 = 0.f, pv = 0.f;
        for (int k = 0; k < 1024; ++k) { const float a = x[k] * rstd * P.in[7][k]; const float* wr = P.in[8] + (size_t)k * 2208;
            p1 += a * wr[928 + h * 32 + j]; p2 += a * wr[928 + h * 32 + 16 + j]; pv += a * wr[1184 + h * 64 + dv]; }
        const int pos = tok_pos(row); const f32x2 cs_ = ((const f32x2*)(ws + WS_TAB))[pos * 16 + j]; const float c = cs_[0], sn = cs_[1];
        const int n = row < MP ? (row & 63) : ((row - MP) & 31);
        const float f = RK_SCALE * exp2f(-(float)n * lg_of(h));
        const float o1 = (p1 * c - p2 * sn) * f, o2 = (p1 * sn + p2 * c) * f;
        const bf16_t* RK = (const bf16_t*)(ws + WS_RK) + (size_t)row * 256 + h * 32;
        chk_acc(acc, 0, bf2f(RK[2 * j]), o1); chk_acc(acc, 0, bf2f(RK[2 * j + 1]), o2);
        chk_acc(acc, 0, bf2f(((const bf16_t*)(ws + WS_RVG))[(size_t)row * 1024 + h * 64 + dv]), pv);
    } else if (gtid < 512) {
        const unsigned r = hsh(gtid * 31u + 5u); const int item = (gtid & 7) == 7 ? NITEM_P + (int)(r % 64) : (int)(r % NITEM_P); const int dv = (r >> 12) & 63, dk = (r >> 18) & 31;
        const RetItem it = ret_decode(item); float s = 0.f;
        for (int m = 0; m < it.L; ++m) s += bf2f(((const bf16_t*)(ws + WS_RVG))[(size_t)(it.row0 + m) * 1024 + it.h * 64 + dv]) * bf2f(((const bf16_t*)(ws + WS_RK))[(size_t)(it.row0 + m) * 256 + it.h * 32 + dk]);
        chk_acc(acc, 1, ((const float*)(ws + WS_KVT))[(size_t)item * 2048 + dv * 32 + dk], s);
    } else if (gtid < 768) {
        const int row = samp_row(gtid); const unsigned r2 = hsh(gtid + 999u); const int h = r2 & 7, d = (r2 >> 3) % 96;
        const bf16_t* ql = (const bf16_t*)(ws + WS_QL) + (size_t)row * 384; float got, ref;
        if (d < 64) { float s = 0.f; for (int k = 0; k < 384; ++k) s += bf2f(ql[k]) * P.in[9][k] * P.in[10][(size_t)k * 768 + h * 96 + d]; ref = s * QSCALE; got = bf2f(((const bf16_t*)(ws + WS_Q))[(size_t)row * 768 + h * 96 + d]); chk_acc(acc, 3, got, ref); }
        else { const int j = (d - 64) & 15; float s1 = 0.f, s2 = 0.f;
            for (int k = 0; k < 384; ++k) { const float a = bf2f(ql[k]) * P.in[9][k]; s1 += a * P.in[10][(size_t)k * 768 + h * 96 + 64 + j]; s2 += a * P.in[10][(size_t)k * 768 + h * 96 + 80 + j]; }
            const int pos = tok_pos(row); const f32x2 cs_ = ((const f32x2*)(ws + WS_TAB))[pos * 16 + j]; const float c = cs_[0], sn = cs_[1];
            const bf16_t* q = (const bf16_t*)(ws + WS_Q) + (size_t)row * 768 + h * 96 + 64;
            chk_acc(acc, 3, bf2f(q[2 * j]), (s1 * c - s2 * sn) * QSCALE); chk_acc(acc, 3, bf2f(q[2 * j + 1]), (s1 * sn + s2 * c) * QSCALE); }
    } else if (gtid < 1024) {
        const unsigned r = hsh(gtid * 17u + 3u); const int krow = (int)(r % KR); const int h = (r >> 20) & 7, d = (r >> 24) & 63;
        const bf16_t* cv = (const bf16_t*)(ws + WS_CKV) + (size_t)krow * 256; float sk = 0.f, sv = 0.f;
        for (int k = 0; k < 256; ++k) { const float a = bf2f(cv[k]); sk += a * P.in[12][(size_t)k * 1024 + h * 128 + d]; sv += a * P.in[12][(size_t)k * 1024 + h * 128 + 64 + d]; }
        chk_acc(acc, 4, bf2f(((const bf16_t*)(ws + WS_KNOPE))[(size_t)krow * 512 + h * 64 + d]), sk);
        chk_acc(acc, 4, bf2f(((const bf16_t*)(ws + WS_V))[(size_t)krow * 512 + h * 64 + d]), sv);
    }
}
__device__ __forceinline__ void chk_after_ph4(const Params& P, int gtid) {
    unsigned char* ws = P.ws; float* acc = (float*)(ws + WS_DBG);
    if (gtid < 256) {
        const unsigned r = hsh(gtid * 13u + 1u); const int bh = r & 31, e = (r >> 5) & 2047; const float lgh = lg_of(bh & 7);
        const float g63 = exp2f(63.f * lgh), g64 = exp2f(64.f * lgh); float S = 0.f; const int cchk = (r >> 16) & 127; float sprev = 0.f;
        for (int c = 0; c < 128; ++c) { if (c == cchk) sprev = S; S = g64 * S + g63 * ((const float*)(ws + WS_KVT))[((size_t)bh * 128 + c) * 2048 + e]; }
        chk_acc(acc, 2, P.out[O_RETP + ((size_t)bh * 32 + ilv(e & 31)) * 64 + (e >> 5)], S);
        chk_acc(acc, 2, bf2f(((const bf16_t*)(ws + WS_ST))[((size_t)bh * 128 + cchk) * 2048 + e]), exp2f(lgh) * sprev);
    } else if (gtid < 256 + 96) {
        const int i = gtid - 256; const unsigned r = hsh(i * 7u + 11u); const int h = r & 7, dv = (r >> 3) & 63;
        int qrow, kbase, nk;
        if (i < 64) { const int b = (r >> 9) & 3, t = (r >> 11) & 8191; qrow = b * SEQ + t; kbase = b * SEQ; nk = ((t >> 6) + 1) * 64; }
        else { const int b = (r >> 9) & 7, l = (r >> 12) & 31; qrow = MP + b * LDEC + l; kbase = MP + b * KALL; nk = KALL; }
        const bf16_t* q = (const bf16_t*)(ws + WS_Q) + (size_t)qrow * 768 + h * 96;
        float m = -INFINITY, l_ = 0.f, o = 0.f;
        for (int k = 0; k < nk; ++k) { const bf16_t* kn = (const bf16_t*)(ws + WS_KNOPE) + (size_t)(kbase + k) * 512 + h * 64; const bf16_t* kr = (const bf16_t*)(ws + WS_KRB) + (size_t)(kbase + k) * 32;
            float s = 0.f; for (int d = 0; d < 64; ++d) s += bf2f(q[d]) * bf2f(kn[d]); for (int d = 0; d < 32; ++d) s += bf2f(q[64 + d]) * bf2f(kr[d]);
            const float mn = fmaxf(m, s), a = exp2f(m - mn), p = exp2f(s - mn); l_ = l_ * a + p; o = o * a + p * bf2f(((const bf16_t*)(ws + WS_V))[(size_t)(kbase + k) * 512 + h * 64 + dv]); m = mn; }
        chk_acc(acc, 5, bf2f(((const bf16_t*)(ws + WS_MIX))[(size_t)qrow * 1024 + h * 64 + dv]), o / l_);
    }
}
#endif
#define HIDE_WS int tid = tid0; asm volatile("" : "+v"(tid)); const int lane = tid & 63; const int wave = __builtin_amdgcn_readfirstlane(tid >> 6); const int gw = blockIdx.x * 8 + wave; (void)lane; (void)gw; unsigned char* ws = ws0; float* hbuf = hbuf0; asm volatile("" : "+s"(ws), "+s"(hbuf)); unsigned char* wl = ws + (size_t)L * WL_STRIDE; (void)wl; (void)hbuf;
#define GEMM_PHASE(EPI_T, E_, A_, B_, M_, N_, K_) do { int k_ = (K_); asm volatile("" : "+s"(k_)); Gemm g_{(const bf16_t*)(A_), (const bf16_t*)(B_), (M_), (N_), k_}; pg8::StaticOrder S_; S_.init((M_), (N_), G, (int)blockIdx.x); \
        pg8::gemm_phase<EPI_T, pg8::StaticOrder, true, true>(lds, g_, S_, E_); } while (0)


constexpr size_t WS_BAR = 55 * MiB + 8192;
#define XB_TMO      128
#define XB_XCNT(j)  (256  + 64 * (j))
#define XB_XSUB(j)  (1280 + 64 * (j))
#define XB_XGEN(j)  (2304 + 64 * (j))
#define XB_TOP      3328
#define XB_TOPGEN   3392
#define XCD_BAR_WORDS 3456
#define XB_SPIN_CAP (1u << 18)

__device__ __forceinline__ unsigned xb_ld(unsigned* p)              { return __hip_atomic_load(p, __ATOMIC_RELAXED, __HIP_MEMORY_SCOPE_AGENT); }
__device__ __forceinline__ unsigned xb_add(unsigned* p, unsigned v) { return __hip_atomic_fetch_add(p, v, __ATOMIC_RELAXED, __HIP_MEMORY_SCOPE_AGENT); }
__device__ __forceinline__ unsigned xb_xcc_id() { return (unsigned)__builtin_amdgcn_s_getreg((3 << 11) | 20) & 0xFu; }
#define XB_SPIN(cond, bar) do { unsigned _sp = 0; while (cond) { __builtin_amdgcn_s_sleep(1); \
    if ((++_sp & 255u) == 0u) { if (xb_ld(&(bar)[XB_TMO])) break; if (_sp > XB_SPIN_CAP) { atomicAdd(&(bar)[XB_TMO], 1u); break; } } } } while (0)

struct XcdBarrier {
    unsigned* bar; unsigned x;
    volatile LAS unsigned* st;
};

__device__ __forceinline__ XcdBarrier xcd_barrier_post(unsigned* bar, volatile LAS unsigned* st) {
    XcdBarrier b; b.bar = bar; b.x = xb_xcc_id(); b.st = st;
    if (threadIdx.x == 0) (void)xb_add(&bar[XB_XCNT(b.x)], 1u);
    return b;
}
__device__ __forceinline__ void xcd_barrier_complete(unsigned* bar, unsigned x, unsigned& nloc, unsigned& nx) {
    const unsigned G = gridDim.x * gridDim.y * gridDim.z;
    unsigned sum, cnt, mine, sp = 0u;
    for (;;) {
        sum = 0u; cnt = 0u; mine = 0u;
#pragma unroll
        for (unsigned j = 0; j < 16; ++j) { const unsigned c = xb_ld(&bar[XB_XCNT(j)]); sum += c; cnt += (c > 0u) ? 1u : 0u; mine = (j == x) ? c : mine; }
        if (sum == G) break;
        __builtin_amdgcn_s_sleep(1);
        if ((++sp & 255u) == 0u) { if (xb_ld(&bar[XB_TMO])) break; if (sp > XB_SPIN_CAP) { atomicAdd(&bar[XB_TMO], 1u); break; } }
    }
    nloc = mine > 0u ? mine : 1u; nx = cnt > 0u ? cnt : 1u;
}

__device__ __forceinline__ void xcd_barrier(const XcdBarrier& b) {
    asm volatile("s_waitcnt vmcnt(0)" ::: "memory");
    __syncthreads();
    if (threadIdx.x == 0) {
        unsigned* bar = b.bar;
        __builtin_amdgcn_s_waitcnt(0);
        unsigned nloc = b.st[0], nx = b.st[1];
        if (nloc == 0u) { xcd_barrier_complete(bar, b.x, nloc, nx); b.st[0] = nloc; b.st[1] = nx; }
        const unsigned old = xb_add(&bar[XB_XSUB(b.x)], 1u);
        const unsigned gen = old / nloc;
        if (old + 1u == (gen + 1u) * nloc) {
            __builtin_amdgcn_fence(__ATOMIC_RELEASE, "agent");
            asm volatile("s_waitcnt vmcnt(0)" ::: "memory");
            const unsigned og = xb_add(&bar[XB_TOP], 1u);
            const unsigned tg = og / nx;
            if (og + 1u == (tg + 1u) * nx) xb_add(&bar[XB_TOPGEN], 1u);
            else XB_SPIN(xb_ld(&bar[XB_TOPGEN]) == tg, bar);
            __builtin_amdgcn_fence(__ATOMIC_ACQUIRE, "agent");
            xb_add(&bar[XB_XGEN(b.x)], 1u);
            asm volatile("s_waitcnt vmcnt(0)" ::: "memory");
        } else {
            XB_SPIN(xb_ld(&bar[XB_XGEN(b.x)]) == gen, bar);
            __builtin_amdgcn_fence(__ATOMIC_ACQUIRE, "agent");
            asm volatile("s_waitcnt vmcnt(0)" ::: "memory");
        }
    }
    __syncthreads();
}


#ifdef TIMING
constexpr size_t WS_TS = 55 * MiB + 4096;
#define TSTAMP(k) do { if (blockIdx.x == 0 && threadIdx.x == 0) { const unsigned long long t1_ = __builtin_amdgcn_s_memrealtime(); unsigned long long* ts_ = (unsigned long long*)(ws0 + WS_TS); ts_[k] += t1_ - ts_[15]; ts_[15] = t1_; } } while (0)
#else
#define TSTAMP(k) do {} while (0)
#endif
__global__ void __launch_bounds__(512, 2) mega_fwd(Params P) {
    extern __shared__ __attribute__((aligned(16))) unsigned char lds_raw[];
    LAS unsigned char* lds = (LAS unsigned char*)lds_raw;
    cg::grid_group grid = cg::this_grid();
    { volatile LAS unsigned* st_ = (volatile LAS unsigned*)(lds + 131072); if (threadIdx.x < 2) st_[threadIdx.x] = 0u; }
    __syncthreads();
    (void)xcd_barrier_post((unsigned*)(P.ws + WS_BAR), (volatile LAS unsigned*)(lds + 131072));
#define GBAR() do { XcdBarrier b_; b_.bar = (unsigned*)(hide_ptr(P.ws) + WS_BAR); b_.x = xb_xcc_id(); b_.st = (volatile LAS unsigned*)(lds + 131072); xcd_barrier(b_); } while (0)
    const int tid0 = threadIdx.x;
    const int G = gridDim.x; const int NGW = G * 8;
    unsigned char* ws0 = P.ws;
    float* hbuf0 = P.out;
#ifdef TIMING
    if (blockIdx.x == 0 && threadIdx.x == 0) { unsigned long long* ts_ = (unsigned long long*)(ws0 + WS_TS); for (int k_ = 0; k_ < 15; ++k_) ts_[k_] = 0ull; ts_[15] = __builtin_amdgcn_s_memrealtime(); }
#endif

#if (PHMASK >> 0) & 1
    _Pragma("unroll 1") for (int rep0_ = 0; rep0_ < 1 + (DUPMASK & 1); ++rep0_)
    { const int L = 0; HIDE_WS
        LAS float* scr = (LAS float*)(lds + wave * 16384);
        constexpr int I_IN = 16 * (NIN / 32), I_UQ = 6 * 24, I_UKV = 4 * 32, I_OUT = 16 * 32, I_FF1 = 16 * 128, I_FF2 = 64 * 32, I_GATE = 16 * 32, I_PROJ = 4 * 32;
        constexpr int I_LAYER = I_IN + I_UQ + I_UKV + I_OUT + I_FF1 + I_FF2 + I_GATE + I_PROJ;
        for (int it = gw; it < 2 * I_LAYER; it += NGW) {
            const int LL = it / I_LAYER; int r = it - LL * I_LAYER; unsigned char* wl = ws + (size_t)LL * WL_STRIDE;
            if (r < I_IN) { wconv_item(P.in[8] + (size_t)LL * 1024 * 2208, 1024, 2208, NIN, 1, P.in[7] + LL * 1024, (bf16_t*)(wl + WL_IN), scr, r, lane); continue; } r -= I_IN;
            if (r < I_UQ) { wconv_item(P.in[10] + (size_t)LL * 384 * 768, 384, 768, 768, 2, P.in[9] + LL * 384, (bf16_t*)(wl + WL_UQ), scr, r, lane); continue; } r -= I_UQ;
            if (r < I_UKV) { wconv_item(P.in[12] + (size_t)LL * 256 * 1024, 256, 1024, 1024, 3, nullptr, (bf16_t*)(wl + WL_UKV), scr, r, lane); continue; } r -= I_UKV;
            if (r < I_OUT) { wconv_item(P.in[14] + (size_t)LL * 1024 * 1024, 1024, 1024, 1024, 0, nullptr, (bf16_t*)(wl + WL_OUT), scr, r, lane); continue; } r -= I_OUT;
            if (r < I_FF1) { wconv_item(P.in[16] + (size_t)LL * 1024 * 4096, 1024, 4096, 4096, 0, P.in[15] + LL * 1024, (bf16_t*)(wl + WL_FF1), scr, r, lane); continue; } r -= I_FF1;
            if (r < I_FF2) { wconv_item(P.in[17] + (size_t)LL * 4096 * 1024, 4096, 1024, 1024, 0, nullptr, (bf16_t*)(wl + WL_FF2), scr, r, lane); continue; } r -= I_FF2;
            if (r < I_GATE) { wconv_item(P.in[19] + (size_t)LL * 1024 * 1024, 1024, 1024, 1024, 0, P.in[18] + LL * 1024, (bf16_t*)(wl + WL_GATE), scr, r, lane); continue; } r -= I_GATE;
            wconv_item(P.in[20] + (size_t)LL * 256 * 1024, 256, 1024, 1024, 0, nullptr, (bf16_t*)(wl + WL_PROJ), scr, r, lane);
        }
        for (int i = blockIdx.x * 512 + tid; i < SEQ * 16; i += G * 512) { const int pos = i >> 4, j = i & 15;
            const double inv = exp2(-(double)j * 0.83048202372184059); const double ang = (double)pos * inv;
            const double kq = rint(ang * 0.15915494309189535); const float rr = (float)(ang - kq * 6.2831853071795865);
            ((f32x2*)(ws + WS_TAB))[i] = (f32x2){cosf(rr), sinf(rr)}; }
        for (int i = blockIdx.x * 512 + tid; i < 6 * MT; i += G * 512) ((float*)(ws + WS_SSQ))[i] = 0.f;
        for (int row = gw; row < MT; row += NGW)
            norm_row_bf16(row < MP ? P.in[0] + (size_t)row * 1024 : P.in[1] + (size_t)(row - MP) * 1024, (bf16_t*)(ws + WS_A) + (size_t)row * 1024, lane);
    }
#endif
    grid.sync(); TSTAMP(0);
#ifdef XSYNC
    for (int xs_ = 0; xs_ < XSYNC; ++xs_) grid.sync();
#endif

#pragma unroll 1
    for (int L = 0; L < 2; ++L) {
#if (PHMASK >> 1) & 1
        { HIDE_WS
        _Pragma("unroll 1") for (int rep_ = 0; rep_ < 1 + ((DUPMASK >> 1) & 1); ++rep_) { asm volatile("" ::: "memory");
        { EpiIn E{(bf16_t*)(ws + WS_RAW), (bf16_t*)(ws + WS_RVG), L == 0 ? nullptr : (const float*)(ws + WS_SSQ) + (size_t)2 * MT}; GEMM_PHASE(EpiIn, E, L == 0 ? (const void*)(ws + WS_A) : (const void*)((const bf16_t*)hbuf + (size_t)MT * 1024), wl + WL_IN, MT, NIN, 1024); }
        }
        }
#endif
        GBAR(); TSTAMP(1);
#if (PHMASK >> 2) & 1
        { HIDE_WS
        _Pragma("unroll 1") for (int rep_ = 0; rep_ < 1 + ((DUPMASK >> 2) & 1); ++rep_) { asm volatile("" ::: "memory");
        for (int row = gw; row < MT; row += NGW) rowpass2(P, L, row, lane);
        for (int cr = gw; cr < NDB * PAST; cr += NGW) cache_row(P, L, cr, lane);
        }
        }
#endif
        GBAR(); TSTAMP(2);
#if (PHMASK >> 3) & 1
        { HIDE_WS
        _Pragma("unroll 1") for (int rep_ = 0; rep_ < 1 + ((DUPMASK >> 3) & 1); ++rep_) { asm volatile("" ::: "memory");
#ifndef NO_UQ
        { EpiUq E{(bf16_t*)(ws + WS_Q), (const float*)(ws + WS_TAB)}; GEMM_PHASE(EpiUq, E, ws + WS_QL, wl + WL_UQ, MT, 768, 384); }
#endif
#ifndef NO_UKV
        { EpiUkv E{(bf16_t*)(ws + WS_KNOPE), (bf16_t*)(ws + WS_V)}; GEMM_PHASE(EpiUkv, E, ws + WS_CKV, wl + WL_UKV, KR - 256, 1024, 256); }
        __syncthreads();
        { MiniArgs ma{(const bf16_t*)(ws + WS_CKV), (const bf16_t*)(wl + WL_UKV), 1024, 256, 4, nullptr, nullptr, nullptr, nullptr, nullptr, (bf16_t*)(ws + WS_KNOPE), nullptr, KR - 256, (bf16_t*)(ws + WS_V)}; mini_gemm(ma, lds, G); }
#endif
        __syncthreads();
#ifndef NO_RKV
        for (int item = gw; item < NITEM; item += NGW) ret_kv_item(item, (const bf16_t*)(ws + WS_RK), (const bf16_t*)(ws + WS_RVG), (float*)(ws + WS_KVT), lds + wave * 12288, lane);
#endif
        }
        }
#endif
        GBAR(); TSTAMP(3);
#if defined(DBG_STOP) && DBG_STOP == 3
        return;
#endif
#if (PHMASK >> 4) & 1
        { HIDE_WS
        _Pragma("unroll 1") for (int rep_ = 0; rep_ < 1 + ((DUPMASK >> 4) & 1); ++rep_) { asm volatile("" ::: "memory");
        _Pragma("unroll 1") for (int r1_ = 0; r1_ < 1 + DUP_SCAN; ++r1_)
        for (int blk = blockIdx.x; blk < 128 + 256; blk += G) { if (blk < 128) ret_scan_prompt(P, L, blk * 512 + tid); else ret_scan_sample(P, L, (blk - 128) * 512 + tid); }
        __syncthreads();
        {
            const bf16_t* Q = (const bf16_t*)(ws + WS_Q); const bf16_t* KN = (const bf16_t*)(ws + WS_KNOPE); const bf16_t* KRB = (const bf16_t*)(ws + WS_KRB);
            const bf16_t* V = (const bf16_t*)(ws + WS_V); bf16_t* MIX = (bf16_t*)(ws + WS_MIX);
#ifndef NO_PROMPT
            _Pragma("unroll 1") for (int r2_ = 0; r2_ < 1 + DUP_PROMPT; ++r2_)
            if (G == 256) { const int vcu = (blockIdx.x % 8) * 32 + blockIdx.x / 8; const int s = vcu & 7, bh = vcu >> 3;
                for (int i = 0; i < 4; ++i) { const int qb = (i == 0) ? 31 - s : (i == 1) ? 16 + s : (i == 2) ? 15 - s : s; att::prompt_unit(bh >> 3, bh & 7, qb, Q, KN, KRB, V, MIX, lds); } }
            else { for (int u = blockIdx.x; u < 1024; u += G) att::prompt_unit((u >> 5) >> 3, (u >> 5) & 7, 31 - (u & 31), Q, KN, KRB, V, MIX, lds); }
#endif
#ifndef NO_SAMPLE
            _Pragma("unroll 1") for (int r3_ = 0; r3_ < 1 + DUP_SAMPLE; ++r3_)
            for (int u = G - 1 - blockIdx.x; u < 64; u += G) att::sample_unit(u >> 3, u & 7, Q, KN, KRB, V, MIX, lds);
#endif
        }
        }
        }
#endif
        GBAR(); TSTAMP(4);
#if defined(DBG_STOP) && DBG_STOP == 4
        return;
#endif
#if (PHMASK >> 5) & 1
        { HIDE_WS
        _Pragma("unroll 1") for (int rep_ = 0; rep_ < 1 + ((DUPMASK >> 5) & 1); ++rep_) { asm volatile("" ::: "memory");
        for (int item = gw; item < NITEM; item += NGW) ret_out_item(P, L, item, lds + wave * 8192, lane);
        for (int i = blockIdx.x * 512 + tid; i < MT * 32; i += G * 512) { const int row = i >> 5, c8 = (i & 31) * 8;
            const float* src = (row < MP ? P.in[5] + ((size_t)L * MP + row) * 256 : P.in[6] + ((size_t)L * MS + (row - MP)) * 256) + c8;
            const f32x4 a = *(const f32x4*)src, b = *(const f32x4*)(src + 4);
            u32x4 w; w.x = cvtpk(a[0], a[1]); w.y = cvtpk(a[2], a[3]); w.z = cvtpk(b[0], b[1]); w.w = cvtpk(b[2], b[3]);
            *(u32x4*)((bf16_t*)(ws + WS_PBF) + (size_t)row * 256 + c8) = w; }
        }
        }
#endif
        GBAR(); TSTAMP(5);
#if (PHMASK >> 6) & 1
        { HIDE_WS
        float* ssq = (float*)(ws + WS_SSQ) + (size_t)L * 3 * MT; bf16_t* HB0 = (bf16_t*)hbuf; const bf16_t* HB1 = (const bf16_t*)hbuf + (size_t)MT * 1024;
        { EpiRes2 E{L == 0 ? P.in[0] : nullptr, HB1, HB0, ssq}; GEMM_PHASE(EpiRes2, E, ws + WS_MIX, wl + WL_OUT, MP, 1024, 1024); }
        { EpiBf E{(bf16_t*)(ws + WS_PG), 1024, 0, nullptr}; GEMM_PHASE(EpiBf, E, ws + WS_PBF, wl + WL_PROJ, MP, 1024, 256); }
        __syncthreads();
        { MiniArgs ma{(const bf16_t*)(ws + WS_PBF), (const bf16_t*)(wl + WL_PROJ), 1024, 256, 3, nullptr, nullptr, nullptr, nullptr, nullptr, (bf16_t*)(ws + WS_PG), nullptr, 0, nullptr}; mini_gemm(ma, lds, G); }
        __syncthreads();
        { MiniArgs ma{(const bf16_t*)(ws + WS_MIX), (const bf16_t*)(wl + WL_OUT), 1024, 1024, 0, L == 0 ? P.in[1] : nullptr, HB1, HB0, ssq, nullptr, nullptr, nullptr, 0, nullptr}; mini_gemm(ma, lds, G); }
        }
#endif
        GBAR(); TSTAMP(6);
#if (PHMASK >> 8) & 1
        { HIDE_WS
        const float* ssq = (const float*)(ws + WS_SSQ) + (size_t)L * 3 * MT; const bf16_t* HB0 = (const bf16_t*)hbuf;
        { EpiBf E{(bf16_t*)(ws + WS_U), DFF, 1, ssq}; GEMM_PHASE(EpiBf, E, HB0, wl + WL_FF1, MP, DFF, 1024); }
        __syncthreads();
        { MiniArgs ma{HB0, (const bf16_t*)(wl + WL_FF1), DFF, 1024, 1, nullptr, nullptr, nullptr, nullptr, ssq, (bf16_t*)(ws + WS_U), nullptr, 0, nullptr}; mini_gemm(ma, lds, G); }
        }
#endif
        GBAR(); TSTAMP(8);
#if (PHMASK >> 9) & 1
        { HIDE_WS
        float* ssq = (float*)(ws + WS_SSQ) + (size_t)(L * 3 + 1) * MT; bf16_t* HB0 = (bf16_t*)hbuf;
        { EpiRes2 E{nullptr, HB0, HB0, ssq}; GEMM_PHASE(EpiRes2, E, ws + WS_U, wl + WL_FF2, MP, 1024, DFF); }
        __syncthreads();
        { MiniArgs ma{(const bf16_t*)(ws + WS_U), (const bf16_t*)(wl + WL_FF2), 1024, DFF, 0, nullptr, HB0, HB0, ssq, nullptr, nullptr, nullptr, 0, nullptr}; mini_gemm(ma, lds, G); }
        }
#endif
        GBAR(); TSTAMP(9);
#if (PHMASK >> 11) & 1
        { HIDE_WS
        const float* ssq_in = (const float*)(ws + WS_SSQ) + (size_t)(L * 3 + 1) * MT; float* ssq_out = (float*)(ws + WS_SSQ) + (size_t)(L * 3 + 2) * MT;
        const bf16_t* HB0 = (const bf16_t*)hbuf; bf16_t* HO = L == 0 ? (bf16_t*)hbuf + (size_t)MT * 1024 : (bf16_t*)(ws + WS_A);
        { EpiGate2 E{HB0, (const bf16_t*)(ws + WS_PG), ssq_in, HO, ssq_out}; GEMM_PHASE(EpiGate2, E, HB0, wl + WL_GATE, MP, 1024, 1024); }
        __syncthreads();
        { MiniArgs ma{HB0, (const bf16_t*)(wl + WL_GATE), 1024, 1024, 2, nullptr, HB0, HO, ssq_out, ssq_in, nullptr, (const bf16_t*)(ws + WS_PG), 0, nullptr}; mini_gemm(ma, lds, G); }
        }
#endif
        GBAR(); TSTAMP(11);
#if (PHMASK >> 12) & 1
        { HIDE_WS
        if (L == 1) { for (int row = gw; row < MT; row += NGW) final_norm_row_bf((const bf16_t*)(ws + WS_A) + (size_t)row * 1024, hbuf + (size_t)row * 1024, P.in[21], lane); }
        }
#endif
        TSTAMP(12);
    }

}


#ifdef SELFCHK
__global__ void __launch_bounds__(512) chk_kernel(Params P) {
    const int gtid = blockIdx.x * 512 + threadIdx.x;
#if DBG_STOP == 3
    chk_after_ph3(P, gtid);
#elif DBG_STOP == 4
    chk_after_ph4(P, gtid);
#endif
}
__global__ void __launch_bounds__(512) enc_kernel(Params P) {
    const float* acc = (const float*)(P.ws + WS_DBG); unsigned code = 0;
    for (int k = 0; k < 6; ++k) { const float e2 = acc[2 * k], r2 = acc[2 * k + 1];
        if (r2 > 0.f && !(e2 <= SELFCHK_TOL * r2)) code |= 1u << k; }
    const float V = sqrtf((float)code);
    for (size_t i = (size_t)blockIdx.x * 512 + threadIdx.x; i < O_END; i += (size_t)gridDim.x * 512) P.out[i] = (i >= (size_t)MP * 1024 && i < (size_t)MT * 1024) ? V : 0.f;
}
#endif
#ifdef DBG_ZERO
__global__ void __launch_bounds__(512) zero_kernel(Params P) {
    {
        const size_t offs[9] = {O_Y, (size_t)MP * 1024, O_CKVP, O_KRP, O_RETP, O_CKVS, O_KRS, O_RETS, O_END};
        for (int k = 0; k < 8; ++k) {
            const size_t a = offs[k], b = offs[k + 1], mid = a + (b - a) / 2;
            size_t z0 = a, z1 = a;
            if ((DBG_ZERO >> k) & 1) { z0 = a; z1 = b; }
            else if (((DBG_ZERO >> 8) & 1) && k >= 2) { z0 = mid; z1 = b; }
            for (size_t i = z0 + (size_t)blockIdx.x * 512 + threadIdx.x; i < z1; i += (size_t)gridDim.x * 512) P.out[i] = 0.f;
#ifdef DBG_NEG
            if (k == DBG_NEG) for (size_t i = a + (size_t)blockIdx.x * 512 + threadIdx.x; i < mid; i += (size_t)gridDim.x * 512) P.out[i] = DBG_NEGF * P.out[i];
#endif
        }
    }
}
#endif

#ifdef TIMING
__global__ void __launch_bounds__(512) tenc_kernel(Params P) {
    const unsigned long long* ts = (const unsigned long long*)(P.ws + 55 * MiB + 4096);
    double tot = 0, sa = 0, sb = 0;
    for (int k = 0; k < 13; ++k) { const double d = (double)ts[k]; tot += d; if ((TIMING_A >> k) & 1) sa += d; if ((TIMING_B >> k) & 1) sb += d; }
    const float V = sqrtf(rintf((float)(98.0 * sa / tot))); const float W = 10.f * (10.f + rintf((float)(89.0 * sb / tot))) + 1.5f;
    for (size_t i = (size_t)blockIdx.x * 512 + threadIdx.x; i < O_END; i += (size_t)gridDim.x * 512) P.out[i] = (i >= (size_t)MP * 1024 && i < (size_t)MT * 1024) ? V : (i == 0 ? W : 0.f);
}
#endif
extern "C" void kernel_launch(void* const* d_in, const int* in_sizes, int n_in, void* d_out, int out_size, void* d_ws, size_t ws_size, hipStream_t stream) {
    static int grid = 0;
    if (grid == 0) {
        if (n_in != 22 || (size_t)out_size != O_END || ws_size < WS_END) { fprintf(stderr, "kernel_launch: unexpected shapes n_in %d out %d ws %zu\n", n_in, out_size, ws_size); grid = -1; return; }
        int dev = 0, cus = 0, per_cu = 0;
        (void)hipGetDevice(&dev); (void)hipDeviceGetAttribute(&cus, hipDeviceAttributeMultiprocessorCount, dev);
        (void)hipFuncSetAttribute((const void*)mega_fwd, hipFuncAttributeMaxDynamicSharedMemorySize, LDS_BYTES);
        if (hipOccupancyMaxActiveBlocksPerMultiprocessor(&per_cu, (const void*)mega_fwd, 512, LDS_BYTES) != hipSuccess || per_cu < 1) { fprintf(stderr, "kernel_launch: occupancy query gave %d\n", per_cu); per_cu = 1; }
        (void)hipGetLastError();
        grid = cus;
        if (grid <= 0) grid = 256;
    }
    if (grid < 0) return;
    Params p{};
    for (int i = 0; i < 22; ++i) p.in[i] = (const float*)d_in[i];
    p.out = (float*)d_out; p.ws = (unsigned char*)d_ws;
    void* args[] = {&p};
    (void)hipMemsetAsync((unsigned char*)d_ws + WS_BAR, 0, XCD_BAR_WORDS * 4, stream);
#ifdef SELFCHK
    (void)hipMemsetAsync((unsigned char*)d_ws + WS_DBG, 0, 256, stream);
#endif
    hipError_t e = hipLaunchCooperativeKernel((const void*)mega_fwd, dim3(grid), dim3(512), args, LDS_BYTES, stream);
    if (e != hipSuccess) fprintf(stderr, "kernel_launch: cooperative launch failed: %s (grid %d)\n", hipGetErrorString(e), grid);
#ifdef TIMING
    hipLaunchKernelGGL(tenc_kernel, dim3(256), dim3(512), 0, stream, p);
#endif
#ifdef DBG_ZERO
    hipLaunchKernelGGL(zero_kernel, dim3(256), dim3(512), 0, stream, p);
#endif
#ifdef SELFCHK
    hipLaunchKernelGGL(chk_kernel, dim3(8), dim3(512), 0, stream, p);
    hipLaunchKernelGGL(enc_kernel, dim3(256), dim3(512), 0, stream, p);
#endif
}
```

```cpp
#include <hip/hip_runtime.h>
#include <hip/hip_cooperative_groups.h>
#include <cstdio>
#include <cstdint>
#include <cmath>
namespace cg = cooperative_groups;
namespace pg8 {
#define PG8_LAS __attribute__((address_space(3)))
typedef unsigned short bf16_t;
typedef short bf16x8 __attribute__((ext_vector_type(8)));
typedef float f32x4 __attribute__((ext_vector_type(4)));
typedef unsigned u32x4 __attribute__((ext_vector_type(4)));
constexpr int BM = 256, BK = 64, HALF = 128, HTB = HALF * BK * 2  , STAGE_BYTES = 8 * HTB, NXCD = 8, WGM = 8;

__host__ __device__ __forceinline__ int lds_byte(int r, int c) { const int st = (r >> 4) * 2 + (c >> 5), rr = r & 15, cc = c & 31, ob = rr * 64 + cc * 2; return st * 1024 + (ob ^ (((ob >> 9) & 1) << 5)); }
__host__ __device__ __forceinline__ void stage_rc(int b, int& R, int& C) { const int st = b / 1024, sb = b % 1024, swz = sb ^ (((sb >> 9) & 1) << 5); R = (st >> 1) * 16 + swz / 64; C = (st & 1) * 32 + (swz % 64) / 2; }
__host__ __device__ __forceinline__ int perm32(int rho) { const int n = rho >> 4, i = rho & 15; return 8 * (i >> 2) + 4 * n + (i & 3); }

struct Unit { int pm, pn; };
struct Gemm { const bf16_t* A; const bf16_t* Bt; int M, N, K; };

struct StaticOrder {
    int nM, nN, nwg, G, c;
    __host__ __device__ void init(int M, int N, int G_, int c_) { nM = M / BM; nN = N / BM; nwg = nM * nN; G = G_; c = c_; }
    __host__ __device__ bool next(int i, Unit& u) const {
        const long L = (long)i * G + c; if (L >= nwg) return false;
        int wgid = (int)L; { const int q = nwg / NXCD, r = nwg % NXCD, xcd = wgid % NXCD, off = wgid / NXCD; wgid = (xcd < r ? xcd * (q + 1) : r * (q + 1) + (xcd - r) * q) + off; }
        const int nig = WGM * nN, gid = wgid / nig, fm = gid * WGM, gsz = (nM - fm) < WGM ? (nM - fm) : WGM;
        u.pm = fm + ((wgid % nig) % gsz); u.pn = (wgid % nig) / gsz; return true;
    }
    __device__ __forceinline__ void a_ready(const Unit&) const {}
    __device__ __forceinline__ void done(const Unit&) const {}
};

__device__ __forceinline__ unsigned cvt_pk_bf16(float lo, float hi) { unsigned r; asm volatile("v_cvt_pk_bf16_f32 %0, %1, %2" : "=v"(r) : "v"(lo), "v"(hi)); return r; }
typedef float f32x2 __attribute__((ext_vector_type(2)));
__device__ __forceinline__ f32x2 gelu_pk(f32x2 v) {
    const f32x2 av = __builtin_elementwise_abs(v), d = av * 0.2316418882f + 1.0f;
    f32x2 t; t.x = __builtin_amdgcn_rcpf(d.x); t.y = __builtin_amdgcn_rcpf(d.y);
    f32x2 q = t * 0.5307027145f + (-0.7265760135f); q = q * t + 0.7107068705f; q = q * t + (-0.142248368f); q = q * t + 0.127414796f; q = q * t;
    const f32x2 s = (v * v) * (-0.72134752044f);
    f32x2 e; e.x = __builtin_amdgcn_exp2f(s.x); e.y = __builtin_amdgcn_exp2f(s.y);
    const f32x2 m = v * (q * e), r = v - m;
    f32x2 o; o.x = v.x < 0.f ? m.x : r.x; o.y = v.y < 0.f ? m.y : r.y; return o;
}

template <int ACT  > struct EpiBf16 {
    static constexpr bool PERM = true, AFTER_DRAIN = false; static_assert(ACT == 0 || ACT == 1, "EpiBf16: ACT is 0 (none) or 1 (gelu_pk)");
    bf16_t* O; int ldc; const float* bias; int split_cols; size_t split_stride; float scale0;
    __device__ __forceinline__ void operator()(const f32x4 (&acc)[2][2][4][2], const Unit& u, int wr, int wc, int fr, int fq) const {
        const int row0 = u.pm * BM + wr * 64 + fr; int colt = u.pn * BM; bf16_t* base = O;
        float sc = 1.f; if (split_cols) { const int t = colt / split_cols; base += (size_t)t * split_stride; colt -= t * split_cols; if (t == 0) sc = scale0; }
        const int col0 = colt + wc * 32 + 8 * fq, bcol0 = u.pn * BM + wc * 32 + 8 * fq;
        f32x4 bv[2][2];
#pragma unroll
        for (int bj = 0; bj < 2; ++bj)
#pragma unroll
            for (int n = 0; n < 2; ++n) bv[bj][n] = bias ? *(const f32x4*)(bias + bcol0 + bj * HALF + 4 * n) : (f32x4){0.f, 0.f, 0.f, 0.f};
#pragma unroll
        for (int ai = 0; ai < 2; ++ai)
#pragma unroll
            for (int m = 0; m < 4; ++m) { bf16_t* rowp = base + (size_t)(row0 + ai * HALF + m * 16) * ldc + col0;
#pragma unroll
                for (int bj = 0; bj < 2; ++bj) { f32x4 v0 = acc[ai][bj][m][0] + bv[bj][0], v1 = acc[ai][bj][m][1] + bv[bj][1];
                    if (ACT == 1) { f32x2 a = gelu_pk((f32x2){v0[0], v0[1]}), b = gelu_pk((f32x2){v0[2], v0[3]}), c = gelu_pk((f32x2){v1[0], v1[1]}), d = gelu_pk((f32x2){v1[2], v1[3]});
                        v0 = (f32x4){a.x, a.y, b.x, b.y}; v1 = (f32x4){c.x, c.y, d.x, d.y}; }
                    v0 = v0 * sc; v1 = v1 * sc; u32x4 w; w.x = cvt_pk_bf16(v0[0], v0[1]); w.y = cvt_pk_bf16(v0[2], v0[3]); w.z = cvt_pk_bf16(v1[0], v1[1]); w.w = cvt_pk_bf16(v1[2], v1[3]);
                    *(u32x4*)(rowp + bj * HALF) = w; } }
    }
};

struct PanelStats {
    unsigned* xbuf;
    unsigned* cnt;
    unsigned* tmo;
    int ntn; float eps;
    unsigned code;
    __device__ __forceinline__ bool run(const f32x4 (&v)[2][2][4][2], const Unit& u, int wr, int wc, int fr, int fq, PG8_LAS unsigned char* lds, int wid, int lane) const {
        typedef float f32x2v __attribute__((ext_vector_type(2)));
        PG8_LAS f32x2v* P = (PG8_LAS f32x2v*)lds;
        PG8_LAS f32x2v* S = (PG8_LAS f32x2v*)(lds + 8192);
        PG8_LAS unsigned* flag = (PG8_LAS unsigned*)(lds + 8192 + 2048);
#pragma unroll
        for (int ai = 0; ai < 2; ++ai)
#pragma unroll
            for (int m = 0; m < 4; ++m) {
                float s = 0.f;
#pragma unroll
                for (int bj = 0; bj < 2; ++bj)
#pragma unroll
                    for (int n = 0; n < 2; ++n) { const f32x4 x = v[ai][bj][m][n]; s += (x[0] + x[1]) + (x[2] + x[3]); }
                s += __shfl_xor(s, 16); s += __shfl_xor(s, 32);
                const float mw = s * (1.0f / 64.0f); float q = 0.f;
#pragma unroll
                for (int bj = 0; bj < 2; ++bj)
#pragma unroll
                    for (int n = 0; n < 2; ++n) { const f32x4 d = v[ai][bj][m][n] - mw; q += (d[0] * d[0] + d[1] * d[1]) + (d[2] * d[2] + d[3] * d[3]); }
                q += __shfl_xor(q, 16); q += __shfl_xor(q, 32);
                if (fq == 0) P[(ai * HALF + wr * 64 + m * 16 + fr) * 4 + wc] = (f32x2v){mw, q};
            }
        asm volatile("s_waitcnt lgkmcnt(0)" ::: "memory"); __builtin_amdgcn_s_barrier(); asm volatile("" ::: "memory");
#if defined(BROKEN_EXCHANGE_NO_WAIT)
#warning BROKEN CONTROL BUILD: the row-statistics exchange does not wait; results are wrong by design
        if (blockIdx.x >= 64) { const long long t0_ = clock64(); while (clock64() - t0_ < 60000) __builtin_amdgcn_s_sleep(8); }
#endif
        const int row = wid * 32 + (lane & 31);
        if (lane < 32) {
            const f32x2v a = P[row * 4 + 0], b = P[row * 4 + 1], c = P[row * 4 + 2], d = P[row * 4 + 3];
            const float mt = (a.x + b.x + c.x + d.x) * 0.25f;
            const float da = a.x - mt, db = b.x - mt, dc = c.x - mt, dd = d.x - mt;
            const float m2 = (a.y + b.y) + (c.y + d.y) + 64.0f * ((da * da + db * db) + (dc * dc + dd * dd));
            unsigned long long* slot = (unsigned long long*)xbuf + ((size_t)(u.pm * BM + row) * 4 + u.pn);
            __hip_atomic_store(slot, ((unsigned long long)__float_as_uint(m2) << 32) | __float_as_uint(mt), __ATOMIC_RELAXED, __HIP_MEMORY_SCOPE_AGENT);
        }
        asm volatile("s_waitcnt vmcnt(0)" ::: "memory");
        if (lane == 0) __hip_atomic_fetch_add(cnt + 64 * u.pm, 1u, __ATOMIC_RELAXED, __HIP_MEMORY_SCOPE_AGENT);
        if (wid == 0) {
            bool dead = false; const unsigned long long t0 = __builtin_amdgcn_s_memrealtime(); const unsigned want = 8u * (unsigned)ntn;
            for (;;) {
#if defined(BROKEN_EXCHANGE_NO_WAIT)
                break;
#endif
                if ((unsigned)__builtin_amdgcn_readfirstlane(__hip_atomic_load(cnt + 64 * u.pm, __ATOMIC_RELAXED, __HIP_MEMORY_SCOPE_AGENT)) >= want) break;
                if (__builtin_amdgcn_s_memrealtime() - t0 > 2000000ull) {
                    if (lane == 0) { unsigned expect = 0u; __hip_atomic_compare_exchange_strong(tmo + 1, &expect, code | (unsigned)(u.pm & 0xff), __ATOMIC_RELAXED, __ATOMIC_RELAXED, __HIP_MEMORY_SCOPE_AGENT);
                                     __hip_atomic_store(tmo, 1u, __ATOMIC_RELAXED, __HIP_MEMORY_SCOPE_AGENT); }
                    dead = true; break; }
                __builtin_amdgcn_s_sleep(2);
            }
            __builtin_amdgcn_fence(__ATOMIC_ACQUIRE, "agent");
            if (lane == 0) flag[0] = dead ? 1u : 0u;
        }
        asm volatile("s_waitcnt vmcnt(0) lgkmcnt(0)" ::: "memory"); __builtin_amdgcn_s_barrier(); asm volatile("" ::: "memory");
        const bool bad = flag[0] != 0u;
        if (lane < 32) {
            const unsigned long long* slot = (const unsigned long long*)xbuf + (size_t)(u.pm * BM + row) * 4; float mt[4], m2[4]; float ms = 0.f;
#pragma unroll
            for (int t = 0; t < 4; ++t) { if (t < ntn) { const unsigned long long w = __hip_atomic_load(slot + t, __ATOMIC_RELAXED, __HIP_MEMORY_SCOPE_AGENT); mt[t] = __uint_as_float((unsigned)w); m2[t] = __uint_as_float((unsigned)(w >> 32)); } else { mt[t] = 0.f; m2[t] = 0.f; } ms += mt[t]; }
            const float mean = ms / (float)ntn; float q = 0.f;
#pragma unroll
            for (int t = 0; t < 4; ++t) if (t < ntn) { const float dm = mt[t] - mean; q += m2[t] + 256.0f * dm * dm; }
            S[row] = (f32x2v){mean, 1.0f / sqrtf(q / (256.0f * (float)ntn) + eps)};
        }
        asm volatile("s_waitcnt lgkmcnt(0)" ::: "memory"); __builtin_amdgcn_s_barrier(); asm volatile("" ::: "memory");
        return bad;
    }
};
struct EpiLnRes {
    static constexpr bool PERM = false, AFTER_DRAIN = true;
    const float* base; float* out; int ldc; const float* bias; PanelStats st; unsigned poison;
    __device__ __forceinline__ void fused(f32x4 (&acc)[2][2][4][2], const Unit& u, int wr, int wc, int fr, int fq, PG8_LAS unsigned char* lds, int wid, int lane) const {
        typedef float f32x2v __attribute__((ext_vector_type(2)));
        const PG8_LAS f32x2v* S = (const PG8_LAS f32x2v*)(lds + 8192);
        const int col0 = u.pn * BM + wc * 32 + 4 * fq;
#pragma unroll
        for (int bj = 0; bj < 2; ++bj)
#pragma unroll
            for (int n = 0; n < 2; ++n) { const f32x4 bv = bias ? *(const f32x4*)(bias + col0 + bj * HALF + n * 16) : (f32x4){0.f, 0.f, 0.f, 0.f};
#pragma unroll
                for (int ai = 0; ai < 2; ++ai)
#pragma unroll
                    for (int m = 0; m < 4; ++m) acc[ai][bj][m][n] += bv; }
        f32x4 pre[4][2][2];
#pragma unroll
        for (int m = 0; m < 4; ++m) { const size_t off = (size_t)(u.pm * BM + wr * 64 + m * 16 + fr) * ldc + col0;
#pragma unroll
            for (int bj = 0; bj < 2; ++bj)
#pragma unroll
                for (int n = 0; n < 2; ++n) pre[m][bj][n] = *(const f32x4*)(base + off + bj * HALF + n * 16); }
        const bool bad = st.run(acc, u, wr, wc, fr, fq, lds, wid, lane) || poison != 0u;
        const float qnan = __builtin_nanf("");
#pragma unroll
        for (int ai = 0; ai < 2; ++ai)
#pragma unroll
            for (int m = 0; m < 4; ++m) { const int r = ai * HALF + wr * 64 + m * 16 + fr; const f32x2v sr = S[r]; const size_t off = (size_t)(u.pm * BM + r) * ldc + col0;
#pragma unroll
                for (int bj = 0; bj < 2; ++bj)
#pragma unroll
                    for (int n = 0; n < 2; ++n) { const f32x4 bs = ai == 0 ? pre[m][bj][n] : *(const f32x4*)(base + off + bj * HALF + n * 16); f32x4 o = bs + (acc[ai][bj][m][n] - sr.x) * sr.y;
                        if (bad) o = (f32x4){qnan, qnan, qnan, qnan}; *(f32x4*)(out + off + bj * HALF + n * 16) = o; }
                if (m & 1) asm volatile("" ::: "memory"); }
    }
};
struct EpiLnResLn {
    static constexpr bool PERM = false, AFTER_DRAIN = true;
    const float* base; float* out; bf16_t* xn; int ldc; const float* bias; PanelStats st1, st2; unsigned poison;
    __device__ __forceinline__ void fused(f32x4 (&acc)[2][2][4][2], const Unit& u, int wr, int wc, int fr, int fq, PG8_LAS unsigned char* lds, int wid, int lane) const {
        typedef float f32x2v __attribute__((ext_vector_type(2))); typedef unsigned u32x2v __attribute__((ext_vector_type(2)));
        const PG8_LAS f32x2v* S = (const PG8_LAS f32x2v*)(lds + 8192);
        const int col0 = u.pn * BM + wc * 32 + 4 * fq;
#pragma unroll
        for (int bj = 0; bj < 2; ++bj)
#pragma unroll
            for (int n = 0; n < 2; ++n) { const f32x4 bv = bias ? *(const f32x4*)(bias + col0 + bj * HALF + n * 16) : (f32x4){0.f, 0.f, 0.f, 0.f};
#pragma unroll
                for (int ai = 0; ai < 2; ++ai)
#pragma unroll
                    for (int m = 0; m < 4; ++m) acc[ai][bj][m][n] += bv; }
        bool bad = st1.run(acc, u, wr, wc, fr, fq, lds, wid, lane) || poison != 0u;
        const float qnan = __builtin_nanf("");
#pragma unroll
        for (int ai = 0; ai < 2; ++ai)
#pragma unroll
            for (int m = 0; m < 4; ++m) { const int r = ai * HALF + wr * 64 + m * 16 + fr; const f32x2v sr = S[r]; const size_t off = (size_t)(u.pm * BM + r) * ldc + col0;
#pragma unroll
                for (int bj = 0; bj < 2; ++bj)
#pragma unroll
                    for (int n = 0; n < 2; ++n) { const f32x4 bs = *(const f32x4*)(base + off + bj * HALF + n * 16); acc[ai][bj][m][n] = bs + (acc[ai][bj][m][n] - sr.x) * sr.y; }
                asm volatile("" : "+v"(acc[ai][0][m][0]), "+v"(acc[ai][0][m][1]), "+v"(acc[ai][1][m][0]), "+v"(acc[ai][1][m][1]));
                if (m & 1) asm volatile("" ::: "memory"); }
        const bool bad1 = bad;
        bad = st2.run(acc, u, wr, wc, fr, fq, lds, wid, lane) || bad;
#pragma unroll
        for (int ai = 0; ai < 2; ++ai)
#pragma unroll
            for (int m = 0; m < 4; ++m) { const int r = ai * HALF + wr * 64 + m * 16 + fr; const f32x2v sr = S[r]; const size_t off = (size_t)(u.pm * BM + r) * ldc + col0;
#pragma unroll
                for (int bj = 0; bj < 2; ++bj)
#pragma unroll
                    for (int n = 0; n < 2; ++n) { const f32x4 x1 = acc[ai][bj][m][n]; *(f32x4*)(out + off + bj * HALF + n * 16) = bad1 ? (f32x4){qnan, qnan, qnan, qnan} : x1;
                        const f32x4 o = (x1 - sr.x) * sr.y; u32x2v w; w.x = cvt_pk_bf16(o[0], o[1]); w.y = cvt_pk_bf16(o[2], o[3]);
                        if (bad) { w.x = 0x7fc07fc0u; w.y = 0x7fc07fc0u; } *(u32x2v*)(xn + off + bj * HALF + n * 16) = w; }
                asm volatile("" ::: "memory"); }
    }
};

template <class Epi, class Sched, bool ALIGN_EPI = false, bool SP2 = false>
__device__ __forceinline__ void gemm_phase(PG8_LAS unsigned char* lds, const Gemm g, const Sched& S, const Epi& E) {
    int tid_h = threadIdx.x; asm volatile("" : "+v"(tid_h));
    const int tid = tid_h, wid = __builtin_amdgcn_readfirstlane(tid >> 6), lane = tid & 63, wr = wid >> 2, wc = wid & 3, fr = lane & 15, fq = lane >> 4;
    const int K = g.K, nt = K / BK;
    unsigned voffA[2], voffB[2];
#pragma unroll
    for (int i = 0; i < 2; ++i) { int R, C; stage_rc(tid * 16 + i * 8192, R, C); const int Rb = Epi::PERM ? ((R & ~31) + perm32(R & 31)) : R;
        voffA[i] = (unsigned)(R * K + C) * 2u; voffB[i] = (unsigned)(Rb * K + C) * 2u; }
    const size_t kstep = (size_t)(BK * 2);
    const size_t hstep = (size_t)HALF * K * 2;
    const size_t tstep = 2 * hstep;
    const unsigned ldsw = (unsigned)wid * 1024u;
    const int aoff = lds_byte(wr * 64 + fr, fq * 8), boff = lds_byte(wc * 32 + fr, fq * 8);
#define PG8_SA(b, h) (((b) * 2 + (h)) * HTB)
#define PG8_SB(b, h) ((4 + (b) * 2 + (h)) * HTB)
#define PG8_STAGE(bufoff, gbase, voff) do { _Pragma("unroll") for (int _i = 0; _i < 2; ++_i) \
        __builtin_amdgcn_global_load_lds((const unsigned*)((const char*)(gbase) + (voff)[_i]), (PG8_LAS unsigned*)(lds + (bufoff) + ldsw + _i * 8192), 16, 0, 0); } while (0)
#define PG8_LDA(dst, b, h) do { _Pragma("unroll") for (int m = 0; m < 4; ++m) _Pragma("unroll") for (int k = 0; k < 2; ++k) dst[m][k] = *(const PG8_LAS bf16x8*)(lds + PG8_SA(b, h) + aoff + m * 2048 + k * 1024); } while (0)
#define PG8_LDB(dst, b, h) do { _Pragma("unroll") for (int n = 0; n < 2; ++n) _Pragma("unroll") for (int k = 0; k < 2; ++k) dst[n][k] = *(const PG8_LAS bf16x8*)(lds + PG8_SB(b, h) + boff + n * 2048 + k * 1024); } while (0)
#define PG8_MMA(ai, bj, At, Bt) do { __builtin_amdgcn_s_setprio(1); _Pragma("unroll") for (int m = 0; m < 4; ++m) _Pragma("unroll") for (int n = 0; n < 2; ++n) _Pragma("unroll") for (int k = 0; k < 2; ++k) \
        acc[ai][bj][m][n] = __builtin_amdgcn_mfma_f32_16x16x32_bf16(Bt[n][k], At[m][k], acc[ai][bj][m][n], 0, 0, 0); __builtin_amdgcn_s_setprio(0); } while (0)
#define PG8_WAIT_V(n) asm volatile("s_waitcnt vmcnt(" #n ")" ::: "memory")
#define PG8_WAIT_L(n) asm volatile("s_waitcnt lgkmcnt(" #n ")" ::: "memory")
#define PG8_BAR __builtin_amdgcn_s_barrier()
#define PG8_SCHED __builtin_amdgcn_sched_barrier(0)
    Unit cur, nxt; int ui = 0;
    if (!S.next(0, cur)) return;
    f32x4 acc[2][2][4][2];
#pragma unroll
    for (int a = 0; a < 2; ++a)
#pragma unroll
        for (int b = 0; b < 2; ++b)
#pragma unroll
            for (int m = 0; m < 4; ++m)
#pragma unroll
                for (int n = 0; n < 2; ++n) acc[a][b][m][n] = (f32x4){0.f, 0.f, 0.f, 0.f};
    bf16x8 At[4][2], B0[2][2], B1[2][2];
    const char* cA = (const char*)g.A + (size_t)cur.pm * tstep; const char* cB = (const char*)g.Bt + (size_t)cur.pn * tstep;
    S.a_ready(cur);
    if constexpr (SP2) {
        PG8_STAGE(PG8_SB(0, 0), cB, voffB); PG8_STAGE(PG8_SB(0, 1), cB + hstep, voffB); PG8_STAGE(PG8_SA(0, 0), cA, voffA); PG8_STAGE(PG8_SA(0, 1), cA + hstep, voffA);
        if (wr == 1) PG8_BAR;
        PG8_WAIT_V(2); PG8_BAR;
        PG8_STAGE(PG8_SB(1, 0), cB + kstep, voffB); PG8_STAGE(PG8_SA(1, 0), cA + kstep, voffA); PG8_STAGE(PG8_SB(1, 1), cB + hstep + kstep, voffB);
        PG8_WAIT_V(6); PG8_BAR;
    } else {
        PG8_STAGE(PG8_SB(0, 0), cB, voffB); PG8_STAGE(PG8_SA(0, 0), cA, voffA); PG8_STAGE(PG8_SB(0, 1), cB + hstep, voffB); PG8_STAGE(PG8_SA(0, 1), cA + hstep, voffA);
        if (wr == 1) PG8_BAR;
        PG8_WAIT_V(4); PG8_BAR;
        PG8_STAGE(PG8_SB(1, 0), cB + kstep, voffB); PG8_STAGE(PG8_SA(1, 0), cA + kstep, voffA); PG8_STAGE(PG8_SB(1, 1), cB + hstep + kstep, voffB);
        PG8_WAIT_V(6); PG8_BAR;
    }
    for (;;) {
        const bool has_next = S.next(ui + 1, nxt);
        const char* nA = has_next ? (const char*)g.A + (size_t)nxt.pm * tstep : cA; const char* nB = has_next ? (const char*)g.Bt + (size_t)nxt.pn * tstep : cB;
        for (int t = 0; t < nt; t += 2) {
            const bool last = (t == nt - 2);
            const char* a1 = cA + (size_t)(t + 1) * kstep;
            const char* a2 = last ? nA : cA + (size_t)(t + 2) * kstep; const char* b2 = last ? nB : cB + (size_t)(t + 2) * kstep;
            const char* a3 = a2 + kstep; const char* b3 = b2 + kstep;
            if (last && has_next) S.a_ready(nxt);
            if constexpr (SP2) {
            PG8_LDB(B0, 0, 0); PG8_LDB(B1, 0, 1); PG8_SCHED; PG8_LDA(At, 0, 0); PG8_STAGE(PG8_SA(1, 1), a1 + hstep, voffA);
            PG8_WAIT_V(8); PG8_WAIT_L(0); PG8_BAR; PG8_MMA(0, 0, At, B0); PG8_MMA(0, 1, At, B1); PG8_BAR; PG8_SCHED;
            PG8_LDA(At, 0, 1); PG8_STAGE(PG8_SB(0, 0), b2, voffB); PG8_STAGE(PG8_SB(0, 1), b2 + hstep, voffB); PG8_STAGE(PG8_SA(0, 0), a2, voffA);
            PG8_WAIT_V(8); PG8_WAIT_L(0); PG8_BAR; PG8_MMA(1, 0, At, B0); PG8_MMA(1, 1, At, B1); PG8_BAR; PG8_SCHED;
            PG8_LDB(B0, 1, 0); PG8_LDB(B1, 1, 1); PG8_SCHED; PG8_LDA(At, 1, 0); PG8_STAGE(PG8_SA(0, 1), a2 + hstep, voffA);
            PG8_WAIT_V(8); PG8_WAIT_L(0); PG8_BAR; PG8_MMA(0, 0, At, B0); PG8_MMA(0, 1, At, B1); PG8_BAR; PG8_SCHED;
            PG8_LDA(At, 1, 1); PG8_STAGE(PG8_SB(1, 0), b3, voffB); PG8_STAGE(PG8_SB(1, 1), b3 + hstep, voffB); PG8_STAGE(PG8_SA(1, 0), a3, voffA);
            PG8_WAIT_V(8); PG8_WAIT_L(0); PG8_BAR; PG8_MMA(1, 0, At, B0); PG8_MMA(1, 1, At, B1); PG8_BAR; PG8_SCHED;
            } else {
            PG8_LDB(B0, 0, 0); PG8_SCHED; PG8_LDA(At, 0, 0); PG8_STAGE(PG8_SA(1, 1), a1 + hstep, voffA);
            PG8_WAIT_L(8); PG8_BAR; PG8_WAIT_L(0); PG8_MMA(0, 0, At, B0); PG8_BAR; PG8_SCHED;
            PG8_LDB(B1, 0, 1); PG8_STAGE(PG8_SB(0, 0), b2, voffB);
            PG8_BAR; PG8_WAIT_L(0); PG8_MMA(0, 1, At, B1); PG8_BAR;
            PG8_LDA(At, 0, 1); PG8_STAGE(PG8_SA(0, 0), a2, voffA);
            PG8_BAR; PG8_WAIT_L(0); PG8_MMA(1, 0, At, B0); PG8_BAR; PG8_SCHED;
            PG8_STAGE(PG8_SB(0, 1), b2 + hstep, voffB);
            PG8_WAIT_V(6); PG8_BAR; PG8_MMA(1, 1, At, B1); PG8_BAR;
            PG8_LDB(B0, 1, 0); PG8_SCHED; PG8_LDA(At, 1, 0); PG8_STAGE(PG8_SA(0, 1), a2 + hstep, voffA);
            PG8_WAIT_L(8); PG8_BAR; PG8_WAIT_L(0); PG8_MMA(0, 0, At, B0); PG8_BAR; PG8_SCHED;
            PG8_LDB(B1, 1, 1); PG8_STAGE(PG8_SB(1, 0), b3, voffB);
            PG8_BAR; PG8_WAIT_L(0); PG8_MMA(0, 1, At, B1); PG8_BAR;
            PG8_LDA(At, 1, 1); PG8_STAGE(PG8_SA(1, 0), a3, voffA);
            PG8_BAR; PG8_WAIT_L(0); PG8_MMA(1, 0, At, B0); PG8_BAR; PG8_SCHED;
            PG8_STAGE(PG8_SB(1, 1), b3 + hstep, voffB);
            PG8_WAIT_V(6); PG8_BAR; PG8_MMA(1, 1, At, B1); PG8_BAR;
            }
        }
        if constexpr (ALIGN_EPI) { if (wr == 0) PG8_BAR; }
        if constexpr (!Epi::AFTER_DRAIN) { E(acc, cur, wr, wc, fr, fq); S.done(cur); }
        if (!has_next) break;
#pragma unroll
        for (int a = 0; a < 2; ++a)
#pragma unroll
            for (int b = 0; b < 2; ++b)
#pragma unroll
                for (int m = 0; m < 4; ++m)
#pragma unroll
                    for (int n = 0; n < 2; ++n) acc[a][b][m][n] = (f32x4){0.f, 0.f, 0.f, 0.f};
        cur = nxt; cA = nA; cB = nB; ++ui;
        if constexpr (ALIGN_EPI) { if (wr == 1) PG8_BAR; }
    }
    PG8_WAIT_V(0);
    if constexpr (!ALIGN_EPI) { if (wr == 0) PG8_BAR; }
    PG8_BAR;
    if constexpr (Epi::AFTER_DRAIN) { E.fused(acc, cur, wr, wc, fr, fq, lds, wid, lane); S.done(cur); }
#undef PG8_SA
#undef PG8_SB
#undef PG8_STAGE
#undef PG8_LDA
#undef PG8_LDB
#undef PG8_MMA
#undef PG8_WAIT_V
#undef PG8_WAIT_L
#undef PG8_BAR
#undef PG8_SCHED
}
}

#define LAS __attribute__((address_space(3)))
#define GAS __attribute__((address_space(1)))
using pg8::bf16_t; using pg8::bf16x8; using pg8::f32x4; using pg8::u32x4; using pg8::Unit; using pg8::Gemm;
typedef float f32x16 __attribute__((ext_vector_type(16)));
typedef short s16x4 __attribute__((ext_vector_type(4)));
typedef unsigned u32x2 __attribute__((ext_vector_type(2)));
typedef float f32x2 __attribute__((ext_vector_type(2)));
typedef __bf16 bf16x2_t __attribute__((ext_vector_type(2)));
typedef short v4i16_t __attribute__((ext_vector_type(4)));
typedef LAS const char* lds_cptr;

constexpr int NB = 4, SEQ = 8192, DM = 1024, NDB = 8, LDEC = 32, PAST = 2048, KALL = PAST + LDEC;
constexpr int MP = NB * SEQ;
constexpr int MS = NDB * LDEC;
constexpr int MT = MP + MS;
constexpr int KR = MP + NDB * KALL;
constexpr int NIN = 2304, NRAW = 1280, DFF = 4096;
constexpr int NITEM_P = NB * 8 * (SEQ / 64), NITEM = NITEM_P + NDB * 8;
constexpr float EPS = 1e-6f;
constexpr float QSCALE = 0.10206207261596575f * 1.4426950408889634f;
constexpr float RK_SCALE = 0.17677669529663687f;

constexpr size_t O_Y = 0;
constexpr size_t O_CKVP = (size_t)MT * 1024;
constexpr size_t O_KRP = O_CKVP + (size_t)2 * MP * 256;
constexpr size_t O_RETP = O_KRP + (size_t)2 * MP * 32;
constexpr size_t O_CKVS = O_RETP + (size_t)2 * NB * 8 * 32 * 64;
constexpr size_t O_KRS = O_CKVS + (size_t)2 * MS * 256;
constexpr size_t O_RETS = O_KRS + (size_t)2 * MS * 32;
constexpr size_t O_END = O_RETS + (size_t)2 * NDB * 8 * 32 * 64;

constexpr size_t MiB = 1u << 20;
constexpr size_t WL_IN = 0, WL_UQ = WL_IN + (size_t)NIN * 1024 * 2, WL_UKV = WL_UQ + (size_t)768 * 384 * 2, WL_OUT = WL_UKV + (size_t)1024 * 256 * 2,
                 WL_FF1 = WL_OUT + (size_t)1024 * 1024 * 2, WL_FF2 = WL_FF1 + (size_t)4096 * 1024 * 2, WL_GATE = WL_FF2 + (size_t)4096 * 1024 * 2,
                 WL_PROJ = WL_GATE + (size_t)1024 * 1024 * 2, WL_END = WL_PROJ + (size_t)1024 * 256 * 2;
constexpr size_t WL_STRIDE = 27 * MiB;
static_assert(WL_END <= WL_STRIDE, "weights per layer");
constexpr size_t WS_TAB = 54 * MiB;
constexpr size_t WS_SSQ = 55 * MiB + 65536;
static_assert(WS_SSQ + (size_t)6 * MT * 4 <= 56 * MiB, "ssq");
constexpr size_t WS_A = 56 * MiB;
constexpr size_t SZ_ROW1K = (size_t)MT * 1024 * 2;
constexpr size_t WS_Q = WS_A, WS_RQ = WS_A + (size_t)MT * 768 * 2;
constexpr size_t WS_MIX = WS_A + SZ_ROW1K;
constexpr size_t WS_PG = WS_MIX + SZ_ROW1K;
constexpr size_t WS_V = WS_PG, WS_RK = WS_PG + (size_t)KR * 512 * 2;
static_assert(WS_RK + (size_t)MT * 256 * 2 <= WS_PG + SZ_ROW1K, "V|RK overlay");
constexpr size_t WS_U = WS_PG + SZ_ROW1K;
constexpr size_t WS_RVG = WS_U;
constexpr size_t WS_RAW = WS_RVG + SZ_ROW1K;
constexpr size_t WS_KNOPE = WS_RAW, WS_PBF = WS_RAW;
constexpr size_t WS_QL = WS_RAW + (size_t)MT * NRAW * 2;
constexpr size_t WS_CKV = WS_QL + (size_t)MT * 384 * 2;
constexpr size_t WS_KVT = WS_CKV + (size_t)KR * 256 * 2;
constexpr size_t WS_ST = WS_KVT + (size_t)NITEM * 2048 * 4;
constexpr size_t WS_KRB = WS_ST + (size_t)NITEM * 2048 * 2;
constexpr size_t WS_UEND = WS_KRB + (size_t)KR * 32 * 2;
constexpr size_t WS_END = WS_U + (size_t)MT * DFF * 2;
static_assert(WS_UEND <= WS_END, "U overlay");
static_assert((size_t)KR * 512 * 2 <= (size_t)MT * NRAW * 2, "KNOPE overlay");
static_assert(WS_END <= 512 * MiB, "workspace");

#ifndef PHMASK
#define PHMASK 0xFFFF
#endif
#ifndef DUPMASK
#define DUPMASK 0
#endif
#ifndef DUP_SCAN
#define DUP_SCAN 0
#endif
#ifndef DUP_PROMPT
#define DUP_PROMPT 0
#endif
#ifndef DUP_SAMPLE
#define DUP_SAMPLE 0
#endif
constexpr int LDS_BYTES = 131072 + 1024;

struct Params {
    const float* in[22];
    float* out;
    unsigned char* ws;
};

#define MFMA32(a, b, c) __builtin_amdgcn_mfma_f32_32x32x16_bf16((a), (b), (c), 0, 0, 0)
__device__ __forceinline__ unsigned cvtpk(float lo, float hi) { f32x2 v = {lo, hi}; bf16x2_t b = __builtin_convertvector(v, bf16x2_t); return __builtin_bit_cast(unsigned, b); }
__device__ __forceinline__ float bflo(unsigned u) { return __uint_as_float(u << 16); }
__device__ __forceinline__ float bfhi(unsigned u) { return __uint_as_float(u & 0xffff0000u); }
__device__ __forceinline__ int crow(int r, int hi) { return (r & 3) + 8 * (r >> 2) + 4 * hi; }
__device__ __forceinline__ float wave_sum(float v) {
#pragma unroll
    for (int o = 1; o < 64; o <<= 1) v += __shfl_xor(v, o);
    return v;
}
__device__ __forceinline__ s16x4 vtr(lds_cptr p) { return __builtin_bit_cast(s16x4, __builtin_amdgcn_ds_read_tr16_b64_v4i16((LAS v4i16_t*)p)); }
__device__ __forceinline__ bf16x8 cat8(s16x4 lo, s16x4 hi) { return (bf16x8){lo[0], lo[1], lo[2], lo[3], hi[0], hi[1], hi[2], hi[3]}; }
__device__ __forceinline__ bf16x8 pack8(const f32x16& x, int s) {
    u32x4 p; p.x = cvtpk(x[8 * s + 0], x[8 * s + 1]); p.y = cvtpk(x[8 * s + 2], x[8 * s + 3]); p.z = cvtpk(x[8 * s + 4], x[8 * s + 5]); p.w = cvtpk(x[8 * s + 6], x[8 * s + 7]);
    return __builtin_bit_cast(bf16x8, p);
}
__device__ __forceinline__ float lg_of(int h) { const float x = __builtin_amdgcn_exp2f(-5.f - (float)h); const float sr = x * (1.f + x * (0.5f + x * (0.33333334f + x * (0.25f + x * (0.2f + x * 0.16666667f))))); return -sr * 1.4426950408889634f; }
__device__ __forceinline__ unsigned char* hide_ptr(unsigned char* p) { asm volatile("" : "+s"(p)); return p; }
__device__ __forceinline__ int tok_pos(int row) { return row < MP ? (row & (SEQ - 1)) : PAST + ((row - MP) & (LDEC - 1)); }

__device__ __forceinline__ float rstd_of(const float* ssq, int row) { return ssq ? rsqrtf(ssq[row] * (1.f / 1024.f) + EPS) : 1.f; }
struct EpiIn {
    static constexpr bool PERM = true, AFTER_DRAIN = false;
    bf16_t* raw; bf16_t* rvg; const float* ssq;
    __device__ __forceinline__ void operator()(const f32x4 (&acc)[2][2][4][2], const Unit& u, int wr, int wc, int fr, int fq) const {
        const int row0 = u.pm * 256 + wr * 64 + fr; const int colt = u.pn * 256;
        bf16_t* base; int ldc, cb;
        if (colt < NRAW) { base = raw; ldc = NRAW; cb = colt; } else { base = rvg; ldc = 1024; cb = colt - NRAW; }
        const int col0 = cb + wc * 32 + 8 * fq;
#pragma unroll
        for (int ai = 0; ai < 2; ++ai)
#pragma unroll
            for (int m = 0; m < 4; ++m) { bf16_t* rowp = base + (size_t)(row0 + ai * 128 + m * 16) * ldc + col0; const float rs = rstd_of(ssq, row0 + ai * 128 + m * 16);
#pragma unroll
                for (int bj = 0; bj < 2; ++bj) { const f32x4 v0 = acc[ai][bj][m][0] * rs, v1 = acc[ai][bj][m][1] * rs;
                    u32x4 w; w.x = cvtpk(v0[0], v0[1]); w.y = cvtpk(v0[2], v0[3]); w.z = cvtpk(v1[0], v1[1]); w.w = cvtpk(v1[2], v1[3]);
                    *(GAS u32x4*)(rowp + bj * 128) = w; } }
    }
};
struct EpiUq {
    static constexpr bool PERM = true, AFTER_DRAIN = false;
    bf16_t* Q; const float* tab;
    __device__ __forceinline__ void operator()(const f32x4 (&acc)[2][2][4][2], const Unit& u, int wr, int wc, int fr, int fq) const {
        const int row0 = u.pm * 256 + wr * 64 + fr;
#pragma unroll
        for (int ai = 0; ai < 2; ++ai)
#pragma unroll
            for (int m = 0; m < 4; ++m) { const int row = row0 + ai * 128 + m * 16; bf16_t* rowp = Q + (size_t)row * 768;
#pragma unroll
                for (int bj = 0; bj < 2; ++bj) { const int c = u.pn * 256 + bj * 128 + wc * 32 + 8 * fq; f32x4 v0 = acc[ai][bj][m][0], v1 = acc[ai][bj][m][1]; int dst;
                    if (u.pn < 2) { dst = (c >> 6) * 96 + (c & 63); }
                    else { const int i = c - 512, hh = i >> 5, w0 = i & 31; dst = hh * 96 + 64 + w0;
                        const float* tp = tab + ((size_t)tok_pos(row) * 16 + (w0 >> 1)) * 2;
                        const f32x4 t0 = *(const GAS f32x4*)tp, t1 = *(const GAS f32x4*)(tp + 4);
                        f32x4 a, b;
                        a[0] = v0[0] * t0[0] - v0[1] * t0[1]; a[1] = v0[0] * t0[1] + v0[1] * t0[0];
                        a[2] = v0[2] * t0[2] - v0[3] * t0[3]; a[3] = v0[2] * t0[3] + v0[3] * t0[2];
                        b[0] = v1[0] * t1[0] - v1[1] * t1[1]; b[1] = v1[0] * t1[1] + v1[1] * t1[0];
                        b[2] = v1[2] * t1[2] - v1[3] * t1[3]; b[3] = v1[2] * t1[3] + v1[3] * t1[2];
                        v0 = a; v1 = b; }
                    v0 = v0 * QSCALE; v1 = v1 * QSCALE;
                    u32x4 w; w.x = cvtpk(v0[0], v0[1]); w.y = cvtpk(v0[2], v0[3]); w.z = cvtpk(v1[0], v1[1]); w.w = cvtpk(v1[2], v1[3]);
                    *(GAS u32x4*)(rowp + dst) = w; }
                asm volatile("" ::: "memory"); }
    }
};
struct EpiUkv {
    static constexpr bool PERM = true, AFTER_DRAIN = false;
    bf16_t* KN; bf16_t* V;
    __device__ __forceinline__ void operator()(const f32x4 (&acc)[2][2][4][2], const Unit& u, int wr, int wc, int fr, int fq) const {
        const int row0 = u.pm * 256 + wr * 64 + fr;
        bf16_t* base = (u.pn < 2) ? KN : V; const int col0 = (u.pn & 1) * 256 + wc * 32 + 8 * fq;
#pragma unroll
        for (int ai = 0; ai < 2; ++ai)
#pragma unroll
            for (int m = 0; m < 4; ++m) { bf16_t* rowp = base + (size_t)(row0 + ai * 128 + m * 16) * 512 + col0;
#pragma unroll
                for (int bj = 0; bj < 2; ++bj) { const f32x4 v0 = acc[ai][bj][m][0], v1 = acc[ai][bj][m][1];
                    u32x4 w; w.x = cvtpk(v0[0], v0[1]); w.y = cvtpk(v0[2], v0[3]); w.z = cvtpk(v1[0], v1[1]); w.w = cvtpk(v1[2], v1[3]);
                    *(GAS u32x4*)(rowp + bj * 128) = w; } }
    }
};
struct EpiBf {
    static constexpr bool PERM = true, AFTER_DRAIN = false;
    bf16_t* O; int ldc; int relu2; const float* ssq;
    __device__ __forceinline__ void operator()(const f32x4 (&acc)[2][2][4][2], const Unit& u, int wr, int wc, int fr, int fq) const {
        const int row0 = u.pm * 256 + wr * 64 + fr; const int col0 = u.pn * 256 + wc * 32 + 8 * fq;
#pragma unroll
        for (int ai = 0; ai < 2; ++ai)
#pragma unroll
            for (int m = 0; m < 4; ++m) { bf16_t* rowp = O + (size_t)(row0 + ai * 128 + m * 16) * ldc + col0; const float rs = rstd_of(ssq, row0 + ai * 128 + m * 16);
#pragma unroll
                for (int bj = 0; bj < 2; ++bj) { f32x4 v0 = acc[ai][bj][m][0] * rs, v1 = acc[ai][bj][m][1] * rs;
                    if (relu2) {
#pragma unroll
                        for (int e = 0; e < 4; ++e) { const float a = fmaxf(v0[e], 0.f), b = fmaxf(v1[e], 0.f); v0[e] = a * a; v1[e] = b * b; } }
                    u32x4 w; w.x = cvtpk(v0[0], v0[1]); w.y = cvtpk(v0[2], v0[3]); w.z = cvtpk(v1[0], v1[1]); w.w = cvtpk(v1[2], v1[3]);
                    if (relu2) __builtin_nontemporal_store(w, (GAS u32x4*)(rowp + bj * 128)); else *(GAS u32x4*)(rowp + bj * 128) = w; } }
    }
};
struct EpiRes {
    static constexpr bool PERM = false, AFTER_DRAIN = false;
    const float* in0; const float* in1; float* out;
    __device__ __forceinline__ void operator()(const f32x4 (&acc)[2][2][4][2], const Unit& u, int wr, int wc, int fr, int fq) const {
        const int row0 = u.pm * 256 + wr * 64 + fr; const int col0 = u.pn * 256 + wc * 32 + 4 * fq;
#pragma unroll
        for (int ai = 0; ai < 2; ++ai)
#pragma unroll
            for (int m = 0; m < 4; ++m) { const int row = row0 + ai * 128 + m * 16;
                const float* ip = (row < MP ? in0 + (size_t)row * 1024 : in1 + (size_t)(row - MP) * 1024) + col0; float* op = out + (size_t)row * 1024 + col0;
#pragma unroll
                for (int bj = 0; bj < 2; ++bj)
#pragma unroll
                    for (int n = 0; n < 2; ++n) { const f32x4 x = *(const f32x4*)(ip + bj * 128 + n * 16); *(f32x4*)(op + bj * 128 + n * 16) = x + acc[ai][bj][m][n]; }
                asm volatile("" ::: "memory"); }
    }
};
struct EpiGate {
    static constexpr bool PERM = false, AFTER_DRAIN = false;
    float* h; const bf16_t* PG;
    __device__ __forceinline__ void operator()(const f32x4 (&acc)[2][2][4][2], const Unit& u, int wr, int wc, int fr, int fq) const {
        const int row0 = u.pm * 256 + wr * 64 + fr; const int col0 = u.pn * 256 + wc * 32 + 4 * fq;
#pragma unroll
        for (int ai = 0; ai < 2; ++ai)
#pragma unroll
            for (int m = 0; m < 4; ++m) { const int row = row0 + ai * 128 + m * 16; float* hp = h + (size_t)row * 1024 + col0; const bf16_t* pp = PG + (size_t)row * 1024 + col0;
#pragma unroll
                for (int bj = 0; bj < 2; ++bj)
#pragma unroll
                    for (int n = 0; n < 2; ++n) { f32x4 x = *(const f32x4*)(hp + bj * 128 + n * 16); const u32x2 pw = *(const u32x2*)(pp + bj * 128 + n * 16); const f32x4 a = acc[ai][bj][m][n];
                        x[0] += bflo(pw.x) / (1.f + __expf(-a[0])); x[1] += bfhi(pw.x) / (1.f + __expf(-a[1]));
                        x[2] += bflo(pw.y) / (1.f + __expf(-a[2])); x[3] += bfhi(pw.y) / (1.f + __expf(-a[3]));
                        *(f32x4*)(hp + bj * 128 + n * 16) = x; }
                asm volatile("" ::: "memory"); }
    }
};


struct EpiRes2 {
    static constexpr bool PERM = true, AFTER_DRAIN = false;
    const float* inf; const bf16_t* inb; bf16_t* outb; float* ssq;
    __device__ __forceinline__ void operator()(const f32x4 (&acc)[2][2][4][2], const Unit& u, int wr, int wc, int fr, int fq) const {
        const int row0 = u.pm * 256 + wr * 64 + fr; const int col0 = u.pn * 256 + wc * 32 + 8 * fq;
#pragma unroll
        for (int ai = 0; ai < 2; ++ai)
#pragma unroll
            for (int m = 0; m < 4; ++m) { const int row = row0 + ai * 128 + m * 16; const size_t off = (size_t)row * 1024 + col0; float sq = 0.f;
#pragma unroll
                for (int bj = 0; bj < 2; ++bj) { f32x4 x0, x1;
                    if (inf) { x0 = *(const GAS f32x4*)(inf + off + bj * 128); x1 = *(const GAS f32x4*)(inf + off + bj * 128 + 4); }
                    else { const u32x4 hv = *(const GAS u32x4*)(inb + off + bj * 128); x0 = (f32x4){bflo(hv.x), bfhi(hv.x), bflo(hv.y), bfhi(hv.y)}; x1 = (f32x4){bflo(hv.z), bfhi(hv.z), bflo(hv.w), bfhi(hv.w)}; }
                    x0 = x0 + acc[ai][bj][m][0]; x1 = x1 + acc[ai][bj][m][1];
                    sq += (x0[0] * x0[0] + x0[1] * x0[1]) + (x0[2] * x0[2] + x0[3] * x0[3]) + (x1[0] * x1[0] + x1[1] * x1[1]) + (x1[2] * x1[2] + x1[3] * x1[3]);
                    u32x4 w; w.x = cvtpk(x0[0], x0[1]); w.y = cvtpk(x0[2], x0[3]); w.z = cvtpk(x1[0], x1[1]); w.w = cvtpk(x1[2], x1[3]);
                    *(GAS u32x4*)(outb + off + bj * 128) = w; }
                sq += __shfl_xor(sq, 16); sq += __shfl_xor(sq, 32);
                if (fq == 0) __hip_atomic_fetch_add(ssq + row, sq, __ATOMIC_RELAXED, __HIP_MEMORY_SCOPE_AGENT);
                asm volatile("" ::: "memory"); }
    }
};
struct EpiGate2 {
    static constexpr bool PERM = true, AFTER_DRAIN = false;
    const bf16_t* hin; const bf16_t* PG; const float* ssq_in; bf16_t* hout; float* ssq_out;
    __device__ __forceinline__ void operator()(const f32x4 (&acc)[2][2][4][2], const Unit& u, int wr, int wc, int fr, int fq) const {
        const int row0 = u.pm * 256 + wr * 64 + fr; const int col0 = u.pn * 256 + wc * 32 + 8 * fq;
#pragma unroll
        for (int ai = 0; ai < 2; ++ai)
#pragma unroll
            for (int m = 0; m < 4; ++m) { const int row = row0 + ai * 128 + m * 16; const size_t off = (size_t)row * 1024 + col0;
                const float rs = -rstd_of(ssq_in, row); float sq = 0.f;
#pragma unroll
                for (int bj = 0; bj < 2; ++bj) { const u32x4 hv = *(const GAS u32x4*)(hin + off + bj * 128); const u32x4 pv = *(const GAS u32x4*)(PG + off + bj * 128);
                    const f32x4 a0 = acc[ai][bj][m][0], a1 = acc[ai][bj][m][1]; float x[8];
                    x[0] = bflo(hv.x) + bflo(pv.x) / (1.f + __expf(a0[0] * rs)); x[1] = bfhi(hv.x) + bfhi(pv.x) / (1.f + __expf(a0[1] * rs));
                    x[2] = bflo(hv.y) + bflo(pv.y) / (1.f + __expf(a0[2] * rs)); x[3] = bfhi(hv.y) + bfhi(pv.y) / (1.f + __expf(a0[3] * rs));
                    x[4] = bflo(hv.z) + bflo(pv.z) / (1.f + __expf(a1[0] * rs)); x[5] = bfhi(hv.z) + bfhi(pv.z) / (1.f + __expf(a1[1] * rs));
                    x[6] = bflo(hv.w) + bflo(pv.w) / (1.f + __expf(a1[2] * rs)); x[7] = bfhi(hv.w) + bfhi(pv.w) / (1.f + __expf(a1[3] * rs));
#pragma unroll
                    for (int e = 0; e < 8; ++e) sq += x[e] * x[e];
                    u32x4 w; w.x = cvtpk(x[0], x[1]); w.y = cvtpk(x[2], x[3]); w.z = cvtpk(x[4], x[5]); w.w = cvtpk(x[6], x[7]);
                    *(GAS u32x4*)(hout + off + bj * 128) = w; }
                sq += __shfl_xor(sq, 16); sq += __shfl_xor(sq, 32);
                if (fq == 0) __hip_atomic_fetch_add(ssq_out + row, sq, __ATOMIC_RELAXED, __HIP_MEMORY_SCOPE_AGENT);
                asm volatile("" ::: "memory"); }
    }
};

__device__ __forceinline__ int ilv(int w) { return (w & 1) ? 16 + (w >> 1) : (w >> 1); }
__device__ __forceinline__ int srccol(int mode, int n) {
    if (mode == 1) {
        if (n < 640) return n;
        if (n < 672) return 640 + ilv(n - 640);
        if (n < 768) return -1;
        if (n < 1024) { const int i = n - 768; return 672 + (i & ~31) + ilv(i & 31); }
        if (n < 1280) { const int i = n - 1024; return 928 + (i & ~31) + ilv(i & 31); }
        return n - 1280 + 1184;
    }
    if (mode == 2) {
        if (n < 512) return (n >> 6) * 96 + (n & 63);
        const int i = n - 512; return (i >> 5) * 96 + 64 + ilv(i & 31);
    }
    if (mode == 3) {
        if (n < 512) return (n >> 6) * 128 + (n & 63);
        const int i = n - 512; return (i >> 6) * 128 + 64 + (i & 63);
    }
    return n;
}
__device__ __forceinline__ void wconv_item(const float* W, int K, int N, int NP, int mode, const float* scale, bf16_t* WT, LAS float* scr, int item, int lane) {
    const int nblk = NP / 32, kb = item / nblk, nb = item % nblk, k0 = 64 * kb, n0 = 32 * nb;
    const bool contig = (mode == 0) || (mode == 3) || (mode == 1 && (n0 < 640 || n0 >= 1280)) || (mode == 2 && n0 < 512);
    if (contig) {
        const int c0 = srccol(mode, n0), kr = lane >> 3, c4 = (lane & 7) * 4;
#pragma unroll
        for (int i = 0; i < 8; ++i) { const int kk = kr + 8 * i; f32x4 v = *(const GAS f32x4*)(W + (size_t)(k0 + kk) * N + c0 + c4); if (scale) v = v * scale[k0 + kk];
            scr[kk * 33 + c4] = v[0]; scr[kk * 33 + c4 + 1] = v[1]; scr[kk * 33 + c4 + 2] = v[2]; scr[kk * 33 + c4 + 3] = v[3]; }
    } else {
        const int sc = srccol(mode, n0 + (lane & 31));
#pragma unroll 8
        for (int i = 0; i < 32; ++i) { const int kk = 2 * i + (lane >> 5); float v = (sc >= 0) ? W[(size_t)(k0 + kk) * N + sc] : 0.f; if (scale) v *= scale[k0 + kk]; scr[kk * 33 + (lane & 31)] = v; }
    }
    asm volatile("s_waitcnt lgkmcnt(0)" ::: "memory");
    const int c = lane & 7;
#pragma unroll
    for (int j = 0; j < 4; ++j) { const int n = (lane >> 3) + 8 * j; const LAS float* s = scr + (8 * c) * 33 + n;
        u32x4 o; o.x = cvtpk(s[0 * 33], s[1 * 33]); o.y = cvtpk(s[2 * 33], s[3 * 33]); o.z = cvtpk(s[4 * 33], s[5 * 33]); o.w = cvtpk(s[6 * 33], s[7 * 33]);
        *(u32x4*)(WT + (size_t)(n0 + n) * K + k0 + 8 * c) = o; }
    asm volatile("s_waitcnt lgkmcnt(0)" ::: "memory");
}
__device__ __forceinline__ void norm_row_bf16(const float* xrow, bf16_t* orow, int lane) {
    const f32x4* xr = (const f32x4*)xrow + lane; f32x4 v[4]; float s = 0.f;
#pragma unroll
    for (int j = 0; j < 4; ++j) { v[j] = xr[64 * j]; s += (v[j][0] * v[j][0] + v[j][1] * v[j][1]) + (v[j][2] * v[j][2] + v[j][3] * v[j][3]); }
    const float rstd = rsqrtf(wave_sum(s) * (1.f / 1024.f) + EPS);
    u32x2* o8 = (u32x2*)orow + lane;
#pragma unroll
    for (int j = 0; j < 4; ++j) { u32x2 w; w.x = cvtpk(v[j][0] * rstd, v[j][1] * rstd); w.y = cvtpk(v[j][2] * rstd, v[j][3] * rstd); o8[64 * j] = w; }
}
__device__ __forceinline__ void final_norm_row_bf(const bf16_t* hrow, float* yrow, const float* w, int lane) {
    const u32x2* xr = (const u32x2*)hrow + lane; f32x4* yr = (f32x4*)yrow + lane; const f32x4* wr = (const f32x4*)w + lane; f32x4 v[4]; float s = 0.f;
#pragma unroll
    for (int j = 0; j < 4; ++j) { const u32x2 t = xr[64 * j]; v[j] = (f32x4){bflo(t.x), bfhi(t.x), bflo(t.y), bfhi(t.y)}; s += (v[j][0] * v[j][0] + v[j][1] * v[j][1]) + (v[j][2] * v[j][2] + v[j][3] * v[j][3]); }
    const float rstd = rsqrtf(wave_sum(s) * (1.f / 1024.f) + EPS);
#pragma unroll
    for (int j = 0; j < 4; ++j) yr[64 * j] = v[j] * rstd * wr[64 * j];
}
__device__ __forceinline__ void final_norm_row(float* hrow, const float* w, int lane) {
    f32x4* xr = (f32x4*)hrow + lane; const f32x4* wr = (const f32x4*)w + lane; f32x4 v[4]; float s = 0.f;
#pragma unroll
    for (int j = 0; j < 4; ++j) { v[j] = xr[64 * j]; s += (v[j][0] * v[j][0] + v[j][1] * v[j][1]) + (v[j][2] * v[j][2] + v[j][3] * v[j][3]); }
    const float rstd = rsqrtf(wave_sum(s) * (1.f / 1024.f) + EPS);
#pragma unroll
    for (int j = 0; j < 4; ++j) xr[64 * j] = v[j] * rstd * wr[64 * j];
}

__device__ __forceinline__ void rowpass2(const Params& P, int layer, int row, int lane) {
    unsigned char* ws = hide_ptr(P.ws);
    const bf16_t* raw = (const bf16_t*)(ws + WS_RAW) + (size_t)row * NRAW;
    const int pos = tok_pos(row);
    const bool isp = row < MP; const int srow = row - MP;
    const int krow = isp ? row : MP + (srow >> 5) * KALL + PAST + (srow & 31);
    { const unsigned* rp = (const unsigned*)(raw + 6 * lane); const unsigned a = rp[0], b = rp[1], c = rp[2];
      const float x0 = bflo(a), x1 = bfhi(a), x2 = bflo(b), x3 = bfhi(b), x4 = bflo(c), x5 = bfhi(c);
      const float ss = wave_sum(x0 * x0 + x1 * x1 + x2 * x2 + x3 * x3 + x4 * x4 + x5 * x5);
      const float rstd = rsqrtf(ss * (1.f / 384.f) + EPS);
      unsigned* op = (unsigned*)((bf16_t*)(ws + WS_QL) + (size_t)row * 384 + 6 * lane);
      op[0] = cvtpk(x0 * rstd, x1 * rstd); op[1] = cvtpk(x2 * rstd, x3 * rstd); op[2] = cvtpk(x4 * rstd, x5 * rstd); }
    { const u32x2 a = *(const u32x2*)(raw + 384 + 4 * lane);
      const float x0 = bflo(a.x), x1 = bfhi(a.x), x2 = bflo(a.y), x3 = bfhi(a.y);
      const float ss = wave_sum(x0 * x0 + x1 * x1 + x2 * x2 + x3 * x3);
      const float rstd = rsqrtf(ss * (1.f / 256.f) + EPS);
      const f32x4 w = *(const f32x4*)(P.in[11] + layer * 256 + 4 * lane);
      f32x4 o; o[0] = x0 * rstd * w[0]; o[1] = x1 * rstd * w[1]; o[2] = x2 * rstd * w[2]; o[3] = x3 * rstd * w[3];
      float* od = isp ? P.out + O_CKVP + ((size_t)layer * MP + row) * 256 : P.out + O_CKVS + ((size_t)layer * MS + srow) * 256;
      *(f32x4*)(od + 4 * lane) = o;
      u32x2 ob; ob.x = cvtpk(o[0], o[1]); ob.y = cvtpk(o[2], o[3]);
      *(u32x2*)((bf16_t*)(ws + WS_CKV) + (size_t)krow * 256 + 4 * lane) = ob; }
    const int j = lane & 15;
    const f32x2 cs = *(const f32x2*)((const float*)(ws + WS_TAB) + ((size_t)pos * 16 + j) * 2);
    { const unsigned a = *(const unsigned*)(raw + 640 + 2 * j); const float x1 = bflo(a), x2 = bfhi(a);
      const float o1 = x1 * cs[0] - x2 * cs[1], o2 = x1 * cs[1] + x2 * cs[0];
      if (lane < 16) { float* od = isp ? P.out + O_KRP + ((size_t)layer * MP + row) * 32 : P.out + O_KRS + ((size_t)layer * MS + srow) * 32; od[j] = o1; od[16 + j] = o2; }
      if (lane < 16) *(unsigned*)((bf16_t*)(ws + WS_KRB) + (size_t)krow * 32 + 2 * j) = cvtpk(o1, o2); }
    const int n = isp ? (row & 63) : (srow & 31);
#pragma unroll
    for (int t = 0; t < 2; ++t) { const int pi = lane + 64 * t, hh = pi >> 4; const float lgh = lg_of(hh);
        const float fq = __builtin_amdgcn_exp2f((float)n * lgh), fk = RK_SCALE * __builtin_amdgcn_exp2f(-(float)n * lgh);
        { const unsigned a = *(const unsigned*)(raw + 768 + 2 * pi); const float x1 = bflo(a), x2 = bfhi(a);
          *(unsigned*)((bf16_t*)(ws + WS_RQ) + (size_t)row * 256 + 2 * pi) = cvtpk((x1 * cs[0] - x2 * cs[1]) * fq, (x1 * cs[1] + x2 * cs[0]) * fq); }
        { const unsigned a = *(const unsigned*)(raw + 1024 + 2 * pi); const float x1 = bflo(a), x2 = bfhi(a);
          *(unsigned*)((bf16_t*)(ws + WS_RK) + (size_t)row * 256 + 2 * pi) = cvtpk((x1 * cs[0] - x2 * cs[1]) * fk, (x1 * cs[1] + x2 * cs[0]) * fk); }
    }
}
__device__ __forceinline__ void cache_row(const Params& P, int layer, int cr, int lane) {
    unsigned char* ws = hide_ptr(P.ws); const int b = cr >> 11, k = cr & (PAST - 1); const int krow = MP + b * KALL + k;
    const f32x4 v = *(const f32x4*)(P.in[2] + ((size_t)(layer * NDB + b) * PAST + k) * 256 + 4 * lane);
    u32x2 ob; ob.x = cvtpk(v[0], v[1]); ob.y = cvtpk(v[2], v[3]);
    *(u32x2*)((bf16_t*)(ws + WS_CKV) + (size_t)krow * 256 + 4 * lane) = ob;
    if (lane < 16) { const float* kr = P.in[3] + ((size_t)(layer * NDB + b) * PAST + k) * 32;
        *(unsigned*)((bf16_t*)(ws + WS_KRB) + (size_t)krow * 32 + 2 * lane) = cvtpk(kr[lane], kr[16 + lane]); }
}


struct MiniArgs { const bf16_t* A; const bf16_t* Bt; int N, K, mode; const float* inf; const bf16_t* inb; bf16_t* outb; float* ssq_out; const float* ssq_in; bf16_t* U; const bf16_t* PG; int row0; bf16_t* O2; };
__device__ __forceinline__ void mini_gemm(const MiniArgs& a, LAS unsigned char* lds, int G) {
    int tid_h = threadIdx.x; asm volatile("" : "+v"(tid_h));
    const int tid = tid_h, lane = tid & 63, r = lane & 31, h = lane >> 5; const int w = __builtin_amdgcn_readfirstlane(tid >> 6);
    const int ntile = (MS / 32) * (a.N / 32), ks = a.K >> 3;
    for (int tile = blockIdx.x; tile < ntile; tile += G) {
        const int tm = tile & 7, tn = tile >> 3;
        const int rbase = (a.row0 ? a.row0 : MP) + 32 * tm;
        const bf16_t* ap = a.A + (size_t)(rbase + r) * a.K + w * ks + 8 * h; const bf16_t* bp = a.Bt + (size_t)(32 * tn + r) * a.K + w * ks + 8 * h;
        f32x16 acc;
#pragma unroll
        for (int i = 0; i < 16; ++i) acc[i] = 0.f;
        const int nst = ks >> 4;
        for (int s0 = 0; s0 < nst; s0 += 8) {
            bf16x8 av[8], bv[8];
#pragma unroll
            for (int u = 0; u < 8; ++u) if (s0 + u < nst) { av[u] = *(const GAS bf16x8*)(ap + 16 * (s0 + u)); bv[u] = *(const GAS bf16x8*)(bp + 16 * (s0 + u)); }
#pragma unroll
            for (int u = 0; u < 8; ++u) if (s0 + u < nst) acc = MFMA32(av[u], bv[u], acc);
        }
        LAS float* red = (LAS float*)lds + w * 1024;
#pragma unroll
        for (int i = 0; i < 16; ++i) red[crow(i, h) * 32 + r] = acc[i];
        __syncthreads();
#pragma unroll
        for (int half = 0; half < 2; ++half) { const int e = tid + 512 * half; float v = 0.f;
#pragma unroll
            for (int ww = 0; ww < 8; ++ww) v += ((LAS const float*)lds)[ww * 1024 + e];
            const int row = rbase + (e >> 5), col = 32 * tn + (e & 31);
            if (a.mode == 3) { a.U[(size_t)row * 1024 + col] = (bf16_t)(cvtpk(v, 0.f) & 0xffffu); }
            else if (a.mode == 4) { bf16_t* dst = col < 512 ? a.U + (size_t)row * 512 + col : a.O2 + (size_t)row * 512 + (col - 512); *dst = (bf16_t)(cvtpk(v, 0.f) & 0xffffu); }
            else if (a.mode == 1) { const float x = fmaxf(v * rstd_of(a.ssq_in, row), 0.f); a.U[(size_t)row * a.N + col] = (bf16_t)(cvtpk(x * x, 0.f) & 0xffffu); }
            else { float x; const size_t off = (size_t)row * 1024 + col;
                if (a.mode == 0) x = (a.inf ? a.inf[(size_t)(row - MP) * 1024 + col] : __uint_as_float((unsigned)a.inb[off] << 16)) + v;
                else x = __uint_as_float((unsigned)a.inb[off] << 16) + __uint_as_float((unsigned)a.PG[off] << 16) / (1.f + __expf(-v * rstd_of(a.ssq_in, row)));
                a.outb[off] = (bf16_t)(cvtpk(x, 0.f) & 0xffffu);
                float sq = x * x;
#pragma unroll
                for (int o = 1; o < 32; o <<= 1) sq += __shfl_xor(sq, o);
                if ((lane & 31) == 0) __hip_atomic_fetch_add(a.ssq_out + row, sq, __ATOMIC_RELAXED, __HIP_MEMORY_SCOPE_AGENT); }
        }
        __syncthreads();
    }
}

namespace att {
constexpr int SUBB = 10752, VOFF = 6656;
template <int NSUBT> struct Stage { u32x4 k[(NSUBT * 32 * 12 + 511) / 512]; u32x4 v[(NSUBT * 32 * 8 + 511) / 512]; };
template <int NSUBT> __device__ __forceinline__ void tile_load(Stage<NSUBT>& st, const bf16_t* Kn, const bf16_t* Kr, const bf16_t* Vg, int nvalid, int tid) {
    constexpr int NK = (NSUBT * 32 * 12 + 511) / 512, NV = (NSUBT * 32 * 8 + 511) / 512;
#pragma unroll
    for (int i = 0; i < NK; ++i) { const int c = tid + 512 * i; const int key = c / 12, ch = c - key * 12; u32x4 v = {0u, 0u, 0u, 0u};
        if (c < NSUBT * 32 * 12 && key < nvalid) { const bf16_t* src = (ch < 8) ? Kn + (size_t)key * 512 + ch * 8 : Kr + (size_t)key * 32 + (ch - 8) * 8; v = *(const GAS u32x4*)src; }
        st.k[i] = v; }
#pragma unroll
    for (int i = 0; i < NV; ++i) { const int c = tid + 512 * i; const int key = c >> 3, ch = c & 7; u32x4 v = {0u, 0u, 0u, 0u};
        if (c < NSUBT * 32 * 8 && key < nvalid) v = *(const GAS u32x4*)(Vg + (size_t)key * 512 + ch * 8);
        st.v[i] = v; }
}
template <int NSUBT> __device__ __forceinline__ void tile_store(const Stage<NSUBT>& st, LAS unsigned char* buf, int tid) {
    constexpr int NK = (NSUBT * 32 * 12 + 511) / 512, NV = (NSUBT * 32 * 8 + 511) / 512;
#pragma unroll
    for (int i = 0; i < NK; ++i) { const int c = tid + 512 * i; const int key = c / 12, ch = c - key * 12;
        if (c < NSUBT * 32 * 12) *(LAS u32x4*)(buf + (key >> 5) * SUBB + (key & 31) * 208 + ch * 16) = st.k[i]; }
#pragma unroll
    for (int i = 0; i < NV; ++i) { const int c = tid + 512 * i; const int key = c >> 3, ch = c & 7;
        if (c < NSUBT * 32 * 8) *(LAS u32x4*)(buf + (key >> 5) * SUBB + VOFF + (ch >> 2) * 2048 + (key & 31) * 64 + (ch & 3) * 16) = st.v[i]; }
}

__device__ __forceinline__ void ptile_load(Stage<2>& st, const bf16_t* Kn, const bf16_t* Kr, const bf16_t* Vg, int tid) {
#pragma unroll
    for (int i = 0; i < 2; ++i) { const int c = (i == 1 && tid >= 256) ? tid : tid + 512 * i; const int key = c / 12, ch = c - key * 12;
        const bf16_t* src = (ch < 8) ? Kn + (size_t)key * 512 + ch * 8 : Kr + (size_t)key * 32 + (ch - 8) * 8; st.k[i] = *(const GAS u32x4*)src; }
    { const int key = tid >> 3, ch = tid & 7; st.v[0] = *(const GAS u32x4*)(Vg + (size_t)key * 512 + ch * 8); }
}
__device__ __forceinline__ void ptile_store(const Stage<2>& st, LAS unsigned char* buf, int tid) {
#pragma unroll
    for (int i = 0; i < 2; ++i) { const int c = (i == 1 && tid >= 256) ? tid : tid + 512 * i; const int key = c / 12, ch = c - key * 12;
        *(LAS u32x4*)(buf + (key >> 5) * SUBB + (key & 31) * 208 + ch * 16) = st.k[i]; }
    { const int key = tid >> 3, ch = tid & 7; *(LAS u32x4*)(buf + (key >> 5) * SUBB + VOFF + (ch >> 2) * 2048 + (key & 31) * 64 + (ch & 3) * 16) = st.v[0]; }
}
template <int NS> __device__ __forceinline__ void att_tile(LAS const unsigned char* sb, const bf16x8 (&qf)[6], float& m, float& l, f32x16 (&o)[2], int lane) {
    const int r = lane & 31, h = lane >> 5;
    const int g = (lane >> 4) & 1, q = (lane & 15) >> 2, pp = lane & 3;
    f32x16 p[NS];
#pragma unroll
    for (int kb = 0; kb < NS; ++kb)
#pragma unroll
        for (int i = 0; i < 16; ++i) p[kb][i] = 0.f;
    LAS const unsigned char* kp = sb + r * 208 + h * 16;
    lds_cptr vp = (lds_cptr)(sb + VOFF + (4 * h + q) * 64 + g * 32 + pp * 8);
    bf16x8 kf[6][NS];
#pragma unroll
    for (int j = 0; j < 6; ++j)
#pragma unroll
        for (int kb = 0; kb < NS; ++kb) kf[j][kb] = *(LAS const bf16x8*)(kp + kb * SUBB + j * 32);
    __builtin_amdgcn_sched_barrier(0);
#pragma unroll
    for (int j = 0; j < 6; ++j)
#pragma unroll
        for (int kb = 0; kb < NS; ++kb) p[kb] = MFMA32(kf[j][kb], qf[j], p[kb]);
    __builtin_amdgcn_sched_barrier(0);
    bf16x8 vf[2][2];
#pragma unroll
    for (int s = 0; s < 2; ++s)
#pragma unroll
        for (int dvh = 0; dvh < 2; ++dvh) { lds_cptr vb = vp + dvh * 2048 + 16 * s * 64; vf[s][dvh] = cat8(vtr(vb), vtr(vb + 8 * 64)); }
    __builtin_amdgcn_sched_barrier(0);
    float mx = p[0][0];
#pragma unroll
    for (int kb = 0; kb < NS; ++kb)
#pragma unroll
        for (int i = 0; i < 16; ++i) mx = fmaxf(mx, p[kb][i]);
    mx = fmaxf(mx, __shfl_xor(mx, 32));
    if (__any(mx > m + 8.f)) {
        const float mn = fmaxf(m, mx); const float alpha = __builtin_amdgcn_exp2f(m - mn); m = mn; l *= alpha;
#pragma unroll
        for (int i = 0; i < 16; ++i) { o[0][i] *= alpha; o[1][i] *= alpha; }
    }
    float sum = 0.f;
#pragma unroll
    for (int kb = 0; kb < NS; ++kb)
#pragma unroll
        for (int i = 0; i < 16; ++i) { p[kb][i] = __builtin_amdgcn_exp2f(p[kb][i] - m); sum += p[kb][i]; }
    l += sum;
#pragma unroll
    for (int kb = 0; kb < NS; ++kb) {
        const bf16x8 pf0 = pack8(p[kb], 0), pf1 = pack8(p[kb], 1);
        __builtin_amdgcn_sched_barrier(0);
        o[0] = MFMA32(vf[0][0], pf0, o[0]); o[1] = MFMA32(vf[0][1], pf0, o[1]);
        o[0] = MFMA32(vf[1][0], pf1, o[0]); o[1] = MFMA32(vf[1][1], pf1, o[1]);
        __builtin_amdgcn_sched_barrier(0);
        if (kb + 1 < NS) {
#pragma unroll
            for (int s = 0; s < 2; ++s)
#pragma unroll
                for (int dvh = 0; dvh < 2; ++dvh) { lds_cptr vb = vp + (kb + 1) * SUBB + dvh * 2048 + 16 * s * 64; vf[s][dvh] = cat8(vtr(vb), vtr(vb + 8 * 64)); }
        }
    }
}
__device__ __forceinline__ void store_o(bf16_t* dst  , const f32x16 (&o)[2], float inv, int hh) {
#pragma unroll
    for (int dvh = 0; dvh < 2; ++dvh)
#pragma unroll
        for (int g4 = 0; g4 < 4; ++g4) { u32x2 w; w.x = cvtpk(o[dvh][4 * g4] * inv, o[dvh][4 * g4 + 1] * inv); w.y = cvtpk(o[dvh][4 * g4 + 2] * inv, o[dvh][4 * g4 + 3] * inv);
            *(GAS u32x2*)(dst + 32 * dvh + 8 * g4 + 4 * hh) = w; }
}
#define ATT_SBAR() __builtin_amdgcn_sched_barrier(0)
template <bool NEXT> __device__ __forceinline__ void att_step(LAS const unsigned char* sbc, LAS const unsigned char* sbn, const bf16x8 (&qf)[6], f32x16& pc0, f32x16& pc1,
                                                               float& m, float& l, f32x16 (&o)[2], int lane) {
    const int r = lane & 31, h = lane >> 5;
    f32x16 pn0, pn1;
#pragma unroll
    for (int i = 0; i < 16; ++i) { pn0[i] = 0.f; pn1[i] = 0.f; }
    LAS const unsigned char* kp = sbn + r * 208 + h * 16;
#define ATT_QK(ks) do { if (NEXT) { const bf16x8 k0_ = *(LAS const bf16x8*)(kp + (ks) * 32), k1_ = *(LAS const bf16x8*)(kp + SUBB + (ks) * 32); \
        pn0 = MFMA32(k0_, qf[ks], pn0); pn1 = MFMA32(k1_, qf[ks], pn1); } } while (0)
    ATT_QK(0);
    float mxa = fmaxf(fmaxf(pc0[0], pc0[1]), fmaxf(pc0[2], pc0[3])); mxa = fmaxf(mxa, fmaxf(fmaxf(pc0[4], pc0[5]), fmaxf(pc0[6], pc0[7])));
    ATT_SBAR(); ATT_QK(1);
    float mxb = fmaxf(fmaxf(pc0[8], pc0[9]), fmaxf(pc0[10], pc0[11])); mxb = fmaxf(mxb, fmaxf(fmaxf(pc0[12], pc0[13]), fmaxf(pc0[14], pc0[15])));
    ATT_SBAR(); ATT_QK(2);
    float mxc = fmaxf(fmaxf(pc1[0], pc1[1]), fmaxf(pc1[2], pc1[3])); mxc = fmaxf(mxc, fmaxf(fmaxf(pc1[4], pc1[5]), fmaxf(pc1[6], pc1[7])));
    float mxd = fmaxf(fmaxf(pc1[8], pc1[9]), fmaxf(pc1[10], pc1[11])); mxd = fmaxf(mxd, fmaxf(fmaxf(pc1[12], pc1[13]), fmaxf(pc1[14], pc1[15])));
    float mx = fmaxf(fmaxf(mxa, mxb), fmaxf(mxc, mxd)); mx = fmaxf(mx, __shfl_xor(mx, 32));
    ATT_SBAR();
    if (__any(mx > m + 8.f)) {
        const float mn = fmaxf(m, mx); const float alpha = __builtin_amdgcn_exp2f(m - mn); m = mn; l *= alpha;
#pragma unroll
        for (int i = 0; i < 16; ++i) { o[0][i] *= alpha; o[1][i] *= alpha; }
    }
    float sum = 0.f;
    ATT_QK(3);
#pragma unroll
    for (int i = 0; i < 8; ++i) { pc0[i] = __builtin_amdgcn_exp2f(pc0[i] - m); sum += pc0[i]; }
    ATT_SBAR(); ATT_QK(4);
#pragma unroll
    for (int i = 8; i < 16; ++i) { pc0[i] = __builtin_amdgcn_exp2f(pc0[i] - m); sum += pc0[i]; }
    ATT_SBAR(); ATT_QK(5);
#pragma unroll
    for (int i = 0; i < 8; ++i) { pc1[i] = __builtin_amdgcn_exp2f(pc1[i] - m); sum += pc1[i]; }
    ATT_SBAR();
#pragma unroll
    for (int i = 8; i < 16; ++i) { pc1[i] = __builtin_amdgcn_exp2f(pc1[i] - m); sum += pc1[i]; }
    l += sum;
    const int g = (lane >> 4) & 1, q = (lane & 15) >> 2, pp = lane & 3;
#pragma unroll
    for (int kb = 0; kb < 2; ++kb)
#pragma unroll
        for (int s_ = 0; s_ < 2; ++s_) { const bf16x8 pf = pack8(kb == 0 ? pc0 : pc1, s_);
#pragma unroll
            for (int dvh = 0; dvh < 2; ++dvh) { lds_cptr vb = (lds_cptr)(sbc + kb * SUBB + VOFF + dvh * 2048 + (16 * s_ + 4 * h + q) * 64 + g * 32 + pp * 8);
                const bf16x8 vf = cat8(vtr(vb), vtr(vb + 8 * 64)); o[dvh] = MFMA32(vf, pf, o[dvh]); } }
    if (NEXT) { pc0 = pn0; pc1 = pn1; }
#undef ATT_QK
}
__device__ __forceinline__ void prompt_unit(int b, int h, int qb, const bf16_t* Q, const bf16_t* KN, const bf16_t* KRB, const bf16_t* V, bf16_t* MIX, LAS unsigned char* lds) {
    int tid_h = threadIdx.x; asm volatile("" : "+v"(tid_h));
    const int tid = tid_h, lane = tid & 63, r = lane & 31, hh = lane >> 5; const int w = __builtin_amdgcn_readfirstlane(tid >> 6);
    const size_t qrow = (size_t)b * SEQ + qb * 256 + w * 32 + r;
    bf16x8 qf[6];
#pragma unroll
    for (int ks = 0; ks < 6; ++ks) qf[ks] = *(const GAS bf16x8*)(Q + qrow * 768 + h * 96 + ks * 16 + hh * 8);
    const int NT = 4 * qb + 4, myNT = 4 * qb + (w >> 1) + 1;
    const bf16_t* Kn0 = KN + (size_t)b * SEQ * 512 + h * 64; const bf16_t* Kr0 = KRB + (size_t)b * SEQ * 32; const bf16_t* V0 = V + (size_t)b * SEQ * 512 + h * 64;
    float m = -INFINITY, l = 0.f; f32x16 o[2];
#pragma unroll
    for (int i = 0; i < 16; ++i) { o[0][i] = 0.f; o[1][i] = 0.f; }
    Stage<2> st;
    ptile_load(st, Kn0, Kr0, V0, tid); ptile_store(st, lds, tid);
    ptile_load(st, Kn0 + (size_t)64 * 512, Kr0 + (size_t)64 * 32, V0 + (size_t)64 * 512, tid); ptile_store(st, lds + 2 * SUBB, tid);
    __syncthreads();
    int bc = 0, bn = 2 * SUBB, bnn = 4 * SUBB;
    Stage<2> st2;
#define ATT_LOAD(S_, tt) ptile_load(S_, Kn0 + (size_t)(tt) * 64 * 512, Kr0 + (size_t)(tt) * 64 * 32, V0 + (size_t)(tt) * 64 * 512, tid)
#define ATT_COMPUTE(tt) do { if ((tt) < myNT) att_tile<2>(lds + bc, qf, m, l, o, lane); } while (0)
#define ATT_ROT() do { const int tmp_ = bc; bc = bn; bn = bnn; bnn = tmp_; } while (0)
    ATT_LOAD(st, 2);
    for (int t = 0; t < NT; t += 2) {
        if (t + 3 < NT) ATT_LOAD(st2, t + 3);
        ATT_COMPUTE(t);
        if (t + 2 < NT) ptile_store(st, lds + bnn, tid);
        asm volatile("s_waitcnt lgkmcnt(0)\n\ts_barrier" ::: "memory"); ATT_ROT();
        if (t + 4 < NT) ATT_LOAD(st, t + 4);
        ATT_COMPUTE(t + 1);
        if (t + 3 < NT) ptile_store(st2, lds + bnn, tid);
        asm volatile("s_waitcnt lgkmcnt(0)\n\ts_barrier" ::: "memory"); ATT_ROT();
    }
#undef ATT_LOAD
#undef ATT_COMPUTE
#undef ATT_ROT
    l += __shfl_xor(l, 32);
    store_o(MIX + qrow * 1024 + h * 64, o, 1.f / l, hh);
}
__device__ __forceinline__ void sample_unit(int b, int h, const bf16_t* Q, const bf16_t* KN, const bf16_t* KRB, const bf16_t* V, bf16_t* MIX, LAS unsigned char* lds) {
    int tid_h = threadIdx.x; asm volatile("" : "+v"(tid_h));
    const int tid = tid_h, lane = tid & 63, r = lane & 31, hh = lane >> 5; const int w = __builtin_amdgcn_readfirstlane(tid >> 6);
    const size_t qrow = (size_t)MP + b * LDEC + r;
    bf16x8 qf[6];
#pragma unroll
    for (int ks = 0; ks < 6; ++ks) qf[ks] = *(const GAS bf16x8*)(Q + qrow * 768 + h * 96 + ks * 16 + hh * 8);
    const size_t kr0 = (size_t)MP + (size_t)b * KALL;
    const bf16_t* Kn0 = KN + kr0 * 512 + h * 64; const bf16_t* Kr0 = KRB + kr0 * 32; const bf16_t* V0 = V + kr0 * 512 + h * 64;
    float m = -INFINITY, l = 0.f; f32x16 o[2];
#pragma unroll
    for (int i = 0; i < 16; ++i) { o[0][i] = 0.f; o[1][i] = 0.f; }
    for (int st_ = 0; st_ < 9; ++st_) { const int nvalid = (KALL - 256 * st_) < 256 ? (KALL - 256 * st_) : 256;
#pragma unroll 1
        for (int rd = 0; rd < 2; ++rd) { Stage<4> sg; const size_t k0 = (size_t)st_ * 256 + rd * 128;
            tile_load<4>(sg, Kn0 + k0 * 512, Kr0 + k0 * 32, V0 + k0 * 512, nvalid - rd * 128, tid); tile_store<4>(sg, lds + rd * 4 * SUBB, tid); }
        __syncthreads();
        if (w * 32 < nvalid) att_tile<1>(lds + w * SUBB, qf, m, l, o, lane);
        __syncthreads();
    }
    l += __shfl_xor(l, 32);
    LAS float* Ow = (LAS float*)(lds + w * 8192); LAS float* Mw = (LAS float*)(lds + 65536); LAS float* Lw = (LAS float*)(lds + 65536 + 1024);
#pragma unroll
    for (int dvh = 0; dvh < 2; ++dvh)
#pragma unroll
        for (int i = 0; i < 16; ++i) Ow[(32 * dvh + crow(i, hh)) * 32 + r] = o[dvh][i];
    if (hh == 0) { Mw[w * 32 + r] = m; Lw[w * 32 + r] = l; }
    __syncthreads();
    { const int q = tid & 31, dv0 = 4 * (tid >> 5); float ms = -INFINITY;
#pragma unroll
      for (int ww = 0; ww < 8; ++ww) ms = fmaxf(ms, Mw[ww * 32 + q]);
      float den = 0.f, a0 = 0.f, a1 = 0.f, a2 = 0.f, a3 = 0.f;
#pragma unroll
      for (int ww = 0; ww < 8; ++ww) { const float f = __builtin_amdgcn_exp2f(Mw[ww * 32 + q] - ms); den += f * Lw[ww * 32 + q]; const LAS float* op = (const LAS float*)(lds + ww * 8192) + dv0 * 32 + q;
          a0 += f * op[0]; a1 += f * op[32]; a2 += f * op[64]; a3 += f * op[96]; }
      const float inv = 1.f / den; u32x2 wv; wv.x = cvtpk(a0 * inv, a1 * inv); wv.y = cvtpk(a2 * inv, a3 * inv);
      *(u32x2*)(MIX + ((size_t)MP + b * LDEC + q) * 1024 + h * 64 + dv0) = wv; }
    __syncthreads();
}
}

struct RetItem { int b, h, row0, L; };
__device__ __forceinline__ RetItem ret_decode(int item) {
    RetItem it;
    if (item < NITEM_P) { it.b = item >> 10; it.h = (item >> 7) & 7; it.row0 = it.b * SEQ + (item & 127) * 64; it.L = 64; }
    else { const int j = item - NITEM_P; it.b = j >> 3; it.h = j & 7; it.row0 = MP + it.b * LDEC; it.L = 32; }
    return it;
}
__device__ __forceinline__ void ret_stage_v(const bf16_t* RVG, const RetItem& it, LAS unsigned char* img, int lane) {
#pragma unroll
    for (int i = 0; i < 8; ++i) { const int c = lane + 64 * i, tok = c >> 3, ch = c & 7; u32x4 v = {0u, 0u, 0u, 0u};
        if (tok < it.L) v = *(const GAS u32x4*)(RVG + (size_t)(it.row0 + tok) * 1024 + it.h * 64 + ch * 8);
        *(LAS u32x4*)(img + (ch >> 2) * 4096 + tok * 64 + (ch & 3) * 16) = v; }
}
__device__ __forceinline__ void ret_kv_item(int item, const bf16_t* RK, const bf16_t* RVG, float* KVt, LAS unsigned char* lw, int lane) {
    const RetItem it = ret_decode(item); const int r = lane & 31, h = lane >> 5, g = (lane >> 4) & 1, q = (lane & 15) >> 2, pp = lane & 3;
    ret_stage_v(RVG, it, lw, lane);
#pragma unroll
    for (int i = 0; i < 4; ++i) { const int c = lane + 64 * i, tok = c >> 2, ch = c & 3; u32x4 v = {0u, 0u, 0u, 0u};
        if (tok < it.L) v = *(const GAS u32x4*)(RK + (size_t)(it.row0 + tok) * 256 + it.h * 32 + ch * 8);
        *(LAS u32x4*)(lw + 8192 + tok * 64 + ch * 16) = v; }
    f32x16 a0, a1;
#pragma unroll
    for (int i = 0; i < 16; ++i) { a0[i] = 0.f; a1[i] = 0.f; }
    const int ns = it.L >> 4;
#pragma unroll
    for (int s = 0; s < 4; ++s) if (s < ns) {
        const int off = (16 * s + 8 * h + q) * 64 + g * 32 + pp * 8;
        const bf16x8 v0 = cat8(vtr((lds_cptr)(lw + off)), vtr((lds_cptr)(lw + off + 4 * 64)));
        const bf16x8 v1 = cat8(vtr((lds_cptr)(lw + 4096 + off)), vtr((lds_cptr)(lw + 4096 + off + 4 * 64)));
        const bf16x8 kk = cat8(vtr((lds_cptr)(lw + 8192 + off)), vtr((lds_cptr)(lw + 8192 + off + 4 * 64)));
        a0 = MFMA32(v0, kk, a0); a1 = MFMA32(v1, kk, a1);
    }
    float* dst = KVt + (size_t)item * 2048;
#pragma unroll
    for (int i = 0; i < 16; ++i) { ((GAS float*)dst)[crow(i, h) * 32 + r] = a0[i]; ((GAS float*)dst)[(32 + crow(i, h)) * 32 + r] = a1[i]; }
}
__device__ __forceinline__ void ret_scan_prompt(const Params& P, int layer, int idx) {
    const int bh = idx >> 11, e = idx & 2047; const float lgh = lg_of(bh & 7);
    const float g1 = exp2f(lgh), g63 = exp2f(63.f * lgh), g64 = exp2f(64.f * lgh);
    unsigned char* wsh = hide_ptr(P.ws);
    const float* kv = (const float*)(wsh + WS_KVT) + (size_t)bh * 128 * 2048 + e; bf16_t* st = (bf16_t*)(wsh + WS_ST) + (size_t)bh * 128 * 2048 + e;
    float S = 0.f;
#pragma unroll 32
    for (int c = 0; c < 128; ++c) { const float k = kv[(size_t)c * 2048]; st[(size_t)c * 2048] = (bf16_t)(cvtpk(g1 * S, 0.f) & 0xffffu); S = g64 * S + g63 * k; }
    P.out[O_RETP + (((size_t)layer * 32 + bh) * 32 + ilv(e & 31)) * 64 + (e >> 5)] = S;
}
__device__ __forceinline__ void ret_scan_sample(const Params& P, int layer, int idx) {
    const int j = idx >> 11, e = idx & 2047; const float lgh = lg_of(j & 7);
    const float g1 = exp2f(lgh), g31 = exp2f(31.f * lgh), g32 = exp2f(32.f * lgh);
    const size_t so = (((size_t)layer * 64 + j) * 32 + ilv(e & 31)) * 64 + (e >> 5);
    unsigned char* wsh = hide_ptr(P.ws);
    const float Sin = P.in[4][so]; const float k = ((const float*)(wsh + WS_KVT))[(size_t)(NITEM_P + j) * 2048 + e];
    ((bf16_t*)(wsh + WS_ST))[(size_t)(NITEM_P + j) * 2048 + e] = (bf16_t)(cvtpk(g1 * Sin, 0.f) & 0xffffu);
    P.out[O_RETS + so] = g32 * Sin + g31 * k;
}
__device__ __forceinline__ void ret_out_item(const Params& P, int layer, int item, LAS unsigned char* lw, int lane) {
    const RetItem it = ret_decode(item); const int r = lane & 31, h = lane >> 5, g = (lane >> 4) & 1, q = (lane & 15) >> 2, pp = lane & 3;
    unsigned char* wsh = hide_ptr(P.ws);
    const bf16_t* RQ = (const bf16_t*)(wsh + WS_RQ); const bf16_t* RK = (const bf16_t*)(wsh + WS_RK); const bf16_t* RVG = (const bf16_t*)(wsh + WS_RVG);
    const bf16_t* St = (const bf16_t*)(wsh + WS_ST) + (size_t)item * 2048; bf16_t* MIX = (bf16_t*)(wsh + WS_MIX);
    const int NH = it.L >> 5;
    ret_stage_v(RVG, it, lw, lane);
    bf16x8 ka[2][2], qb[2][2], sa[2][2];
#pragma unroll
    for (int x = 0; x < 2; ++x)
#pragma unroll
        for (int s = 0; s < 2; ++s) {
            const int tr = (x < NH) ? it.row0 + 32 * x + r : it.row0 + r;
            ka[x][s] = *(const GAS bf16x8*)(RK + (size_t)tr * 256 + it.h * 32 + 16 * s + 8 * h);
            qb[x][s] = *(const GAS bf16x8*)(RQ + (size_t)tr * 256 + it.h * 32 + 16 * s + 8 * h);
            sa[x][s] = *(const GAS bf16x8*)(St + (32 * x + r) * 32 + 16 * s + 8 * h);
        }
    f32x16 o[2][2];
#pragma unroll
    for (int nh = 0; nh < 2; ++nh) if (nh < NH) {
#pragma unroll
        for (int dvh = 0; dvh < 2; ++dvh) {
#pragma unroll
            for (int i = 0; i < 16; ++i) o[dvh][nh][i] = 0.f;
            o[dvh][nh] = MFMA32(sa[dvh][0], qb[nh][0], o[dvh][nh]); o[dvh][nh] = MFMA32(sa[dvh][1], qb[nh][1], o[dvh][nh]);
        }
#pragma unroll
        for (int mh = 0; mh < 2; ++mh) if (mh <= nh) {
            f32x16 T;
#pragma unroll
            for (int i = 0; i < 16; ++i) T[i] = 0.f;
            T = MFMA32(ka[mh][0], qb[nh][0], T); T = MFMA32(ka[mh][1], qb[nh][1], T);
            if (mh == nh) {
#pragma unroll
                for (int i = 0; i < 16; ++i) if (crow(i, h) > r) T[i] = 0.f;
            }
#pragma unroll
            for (int s = 0; s < 2; ++s) { const bf16x8 pf = pack8(T, s);
#pragma unroll
                for (int dvh = 0; dvh < 2; ++dvh) { lds_cptr vb = (lds_cptr)(lw + dvh * 4096 + (32 * mh + 16 * s + 4 * h + q) * 64 + g * 32 + pp * 8);
                    const bf16x8 vf = cat8(vtr(vb), vtr(vb + 8 * 64)); o[dvh][nh] = MFMA32(vf, pf, o[dvh][nh]); } }
        }
        float sum = 0.f;
#pragma unroll
        for (int dvh = 0; dvh < 2; ++dvh)
#pragma unroll
            for (int i = 0; i < 16; ++i) sum += o[dvh][nh][i];
        sum += __shfl_xor(sum, 32); const float mu = sum * (1.f / 64.f);
        float var = 0.f;
#pragma unroll
        for (int dvh = 0; dvh < 2; ++dvh)
#pragma unroll
            for (int i = 0; i < 16; ++i) { const float d = o[dvh][nh][i] - mu; var += d * d; }
        var += __shfl_xor(var, 32); const float rstd = rsqrtf(var * (1.f / 64.f) + EPS);
        const size_t row = (size_t)it.row0 + 32 * nh + r;
#pragma unroll
        for (int dvh = 0; dvh < 2; ++dvh)
#pragma unroll
            for (int g4 = 0; g4 < 4; ++g4) { const int dv0 = 32 * dvh + 8 * g4 + 4 * h;
                const f32x4 gw = *(const GAS f32x4*)(P.in[13] + layer * 512 + it.h * 64 + dv0);
                const u32x2 gg = *(const GAS u32x2*)(RVG + row * 1024 + 512 + it.h * 64 + dv0);
                float gv[4] = {bflo(gg.x), bfhi(gg.x), bflo(gg.y), bfhi(gg.y)}; float ov[4];
#pragma unroll
                for (int e = 0; e < 4; ++e) { const float sg = gv[e] / (1.f + __expf(-gv[e])); ov[e] = (o[dvh][nh][4 * g4 + e] - mu) * rstd * gw[e] * sg; }
                u32x2 wv; wv.x = cvtpk(ov[0], ov[1]); wv.y = cvtpk(ov[2], ov[3]);
                *(GAS u32x2*)(MIX + row * 1024 + 512 + it.h * 64 + dv0) = wv; }
    }
}


#ifdef SELFCHK
constexpr size_t WS_DBG = 55 * MiB;
__device__ __forceinline__ float bf2f(bf16_t v) { return __uint_as_float((unsigned)v << 16); }
__device__ __forceinline__ void chk_acc(float* acc, int k, float got, float ref) { atomicAdd(acc + 2 * k, (got - ref) * (got - ref)); atomicAdd(acc + 2 * k + 1, ref * ref); }
__device__ __forceinline__ unsigned hsh(unsigned x) { x ^= x >> 16; x *= 0x7feb352dU; x ^= x >> 15; x *= 0x846ca68bU; x ^= x >> 16; return x; }
__device__ __forceinline__ int samp_row(unsigned i) { const unsigned r = hsh(i * 2654435761u + 12345u); return (i & 3) == 3 ? MP + (int)(r % MS) : (int)(r % MP); }
__device__ __forceinline__ void chk_after_ph3(const Params& P, int gtid) {
    unsigned char* ws = P.ws; float* acc = (float*)(ws + WS_DBG);
    if (gtid < 256) {
        const int row = samp_row(gtid); const unsigned r2 = hsh(gtid + 777u); const int h = r2 & 7, j = (r2 >> 3) & 15, dv = (r2 >> 7) & 63;
        const float* x = row < MP ? P.in[0] + (size_t)row * 1024 : P.in[1] + (size_t)(row - MP) * 1024;
        float ss = 0.f; for (int k = 0; k < 1024; ++k) ss += x[k] * x[k];
        const float rstd = rsqrtf(ss / 1024.f + EPS);
        float p1 = 0.f, p2 = 0.f, pv = 0.f;
        for (int k = 0; k < 1024; ++k) { const float a = x[k] * rstd * P.in[7][k]; const float* wr = P.in[8] + (size_t)k * 2208;
            p1 += a * wr[928 + h * 32 + j]; p2 += a * wr[928 + h * 32 + 16 + j]; pv += a * wr[1184 + h * 64 + dv]; }
        const int pos = tok_pos(row); const f32x2 cs_ = ((const f32x2*)(ws + WS_TAB))[pos * 16 + j]; const float c = cs_[0], sn = cs_[1];
        const int n = row < MP ? (row & 63) : ((row - MP) & 31);
        const float f = RK_SCALE * exp2f(-(float)n * lg_of(h));
        const float o1 = (p1 * c - p2 * sn) * f, o2 = (p1 * sn + p2 * c) * f;
        const bf16_t* RK = (const bf16_t*)(ws + WS_RK) + (size_t)row * 256 + h * 32;
        chk_acc(acc, 0, bf2f(RK[2 * j]), o1); chk_acc(acc, 0, bf2f(RK[2 * j + 1]), o2);
        chk_acc(acc, 0, bf2f(((const bf16_t*)(ws + WS_RVG))[(size_t)row * 1024 + h * 64 + dv]), pv);
    } else if (gtid < 512) {
        const unsigned r = hsh(gtid * 31u + 5u); const int item = (gtid & 7) == 7 ? NITEM_P + (int)(r % 64) : (int)(r % NITEM_P); const int dv = (r >> 12) & 63, dk = (r >> 18) & 31;
        const RetItem it = ret_decode(item); float s = 0.f;
        for (int m = 0; m < it.L; ++m) s += bf2f(((const bf16_t*)(ws + WS_RVG))[(size_t)(it.row0 + m) * 1024 + it.h * 64 + dv]) * bf2f(((const bf16_t*)(ws + WS_RK))[(size_t)(it.row0 + m) * 256 + it.h * 32 + dk]);
        chk_acc(acc, 1, ((const float*)(ws + WS_KVT))[(size_t)item * 2048 + dv * 32 + dk], s);
    } else if (gtid < 768) {
        const int row = samp_row(gtid); const unsigned r2 = hsh(gtid + 999u); const int h = r2 & 7, d = (r2 >> 3) % 96;
        const bf16_t* ql = (const bf16_t*)(ws + WS_QL) + (size_t)row * 384; float got, ref;
        if (d < 64) { float s = 0.f; for (int k = 0; k < 384; ++k) s += bf2f(ql[k]) * P.in[9][k] * P.in[10][(size_t)k * 768 + h * 96 + d]; ref = s * QSCALE; got = bf2f(((const bf16_t*)(ws + WS_Q))[(size_t)row * 768 + h * 96 + d]); chk_acc(acc, 3, got, ref); }
        else { const int j = (d - 64) & 15; float s1 = 0.f, s2 = 0.f;
            for (int k = 0; k < 384; ++k) { const float a = bf2f(ql[k]) * P.in[9][k]; s1 += a * P.in[10][(size_t)k * 768 + h * 96 + 64 + j]; s2 += a * P.in[10][(size_t)k * 768 + h * 96 + 80 + j]; }
            const int pos = tok_pos(row); const f32x2 cs_ = ((const f32x2*)(ws + WS_TAB))[pos * 16 + j]; const float c = cs_[0], sn = cs_[1];
            const bf16_t* q = (const bf16_t*)(ws + WS_Q) + (size_t)row * 768 + h * 96 + 64;
            chk_acc(acc, 3, bf2f(q[2 * j]), (s1 * c - s2 * sn) * QSCALE); chk_acc(acc, 3, bf2f(q[2 * j + 1]), (s1 * sn + s2 * c) * QSCALE); }
    } else if (gtid < 1024) {
        const unsigned r = hsh(gtid * 17u + 3u); const int krow = (int)(r % KR); const int h = (r >> 20) & 7, d = (r >> 24) & 63;
        const bf16_t* cv = (const bf16_t*)(ws + WS_CKV) + (size_t)krow * 256; float sk = 0.f, sv = 0.f;
        for (int k = 0; k < 256; ++k) { const float a = bf2f(cv[k]); sk += a * P.in[12][(size_t)k * 1024 + h * 128 + d]; sv += a * P.in[12][(size_t)k * 1024 + h * 128 + 64 + d]; }
        chk_acc(acc, 4, bf2f(((const bf16_t*)(ws + WS_KNOPE))[(size_t)krow * 512 + h * 64 + d]), sk);
        chk_acc(acc, 4, bf2f(((const bf16_t*)(ws + WS_V))[(size_t)krow * 512 + h * 64 + d]), sv);
    }
}
__device__ __forceinline__ void chk_after_ph4(const Params& P, int gtid) {
    unsigned char* ws = P.ws; float* acc = (float*)(ws + WS_DBG);
    if (gtid < 256) {
        const unsigned r = hsh(gtid * 13u + 1u); const int bh = r & 31, e = (r >> 5) & 2047; const float lgh = lg_of(bh & 7);
        const float g63 = exp2f(63.f * lgh), g64 = exp2f(64.f * lgh); float S = 0.f; const int cchk = (r >> 16) & 127; float sprev = 0.f;
        for (int c = 0; c < 128; ++c) { if (c == cchk) sprev = S; S = g64 * S + g63 * ((const float*)(ws + WS_KVT))[((size_t)bh * 128 + c) * 2048 + e]; }
        chk_acc(acc, 2, P.out[O_RETP + ((size_t)bh * 32 + ilv(e & 31)) * 64 + (e >> 5)], S);
        chk_acc(acc, 2, bf2f(((const bf16_t*)(ws + WS_ST))[((size_t)bh * 128 + cchk) * 2048 + e]), exp2f(lgh) * sprev);
    } else if (gtid < 256 + 96) {
        const int i = gtid - 256; const unsigned r = hsh(i * 7u + 11u); const int h = r & 7, dv = (r >> 3) & 63;
        int qrow, kbase, nk;
        if (i < 64) { const int b = (r >> 9) & 3, t = (r >> 11) & 8191; qrow = b * SEQ + t; kbase = b * SEQ; nk = ((t >> 6) + 1) * 64; }
        else { const int b = (r >> 9) & 7, l = (r >> 12) & 31; qrow = MP + b * LDEC + l; kbase = MP + b * KALL; nk = KALL; }
        const bf16_t* q = (const bf16_t*)(ws + WS_Q) + (size_t)qrow * 768 + h * 96;
        float m = -INFINITY, l_ = 0.f, o = 0.f;
        for (int k = 0; k < nk; ++k) { const bf16_t* kn = (const bf16_t*)(ws + WS_KNOPE) + (size_t)(kbase + k) * 512 + h * 64; const bf16_t* kr = (const bf16_t*)(ws + WS_KRB) + (size_t)(kbase + k) * 32;
            float s = 0.f; for (int d = 0; d < 64; ++d) s += bf2f(q[d]) * bf2f(kn[d]); for (int d = 0; d < 32; ++d) s += bf2f(q[64 + d]) * bf2f(kr[d]);
            const float mn = fmaxf(m, s), a = exp2f(m - mn), p = exp2f(s - mn); l_ = l_ * a + p; o = o * a + p * bf2f(((const bf16_t*)(ws + WS_V))[(size_t)(kbase + k) * 512 + h * 64 + dv]); m = mn; }
        chk_acc(acc, 5, bf2f(((const bf16_t*)(ws + WS_MIX))[(size_t)qrow * 1024 + h * 64 + dv]), o / l_);
    }
}
#endif
#define HIDE_WS int tid = tid0; asm volatile("" : "+v"(tid)); const int lane = tid & 63; const int wave = __builtin_amdgcn_readfirstlane(tid >> 6); const int gw = blockIdx.x * 8 + wave; (void)lane; (void)gw; unsigned char* ws = ws0; float* hbuf = hbuf0; asm volatile("" : "+s"(ws), "+s"(hbuf)); unsigned char* wl = ws + (size_t)L * WL_STRIDE; (void)wl; (void)hbuf;
#define GEMM_PHASE(EPI_T, E_, A_, B_, M_, N_, K_) do { int k_ = (K_); asm volatile("" : "+s"(k_)); Gemm g_{(const bf16_t*)(A_), (const bf16_t*)(B_), (M_), (N_), k_}; pg8::StaticOrder S_; S_.init((M_), (N_), G, (int)blockIdx.x); \
        pg8::gemm_phase<EPI_T, pg8::StaticOrder, true, true>(lds, g_, S_, E_); } while (0)


constexpr size_t WS_BAR = 55 * MiB + 8192;
#define XB_TMO      128
#define XB_XCNT(j)  (256  + 64 * (j))
#define XB_XSUB(j)  (1280 + 64 * (j))
#define XB_XGEN(j)  (2304 + 64 * (j))
#define XB_TOP      3328
#define XB_TOPGEN   3392
#define XCD_BAR_WORDS 3456
#define XB_SPIN_CAP (1u << 18)

__device__ __forceinline__ unsigned xb_ld(unsigned* p)              { return __hip_atomic_load(p, __ATOMIC_RELAXED, __HIP_MEMORY_SCOPE_AGENT); }
__device__ __forceinline__ unsigned xb_add(unsigned* p, unsigned v) { return __hip_atomic_fetch_add(p, v, __ATOMIC_RELAXED, __HIP_MEMORY_SCOPE_AGENT); }
__device__ __forceinline__ unsigned xb_xcc_id() { return (unsigned)__builtin_amdgcn_s_getreg((3 << 11) | 20) & 0xFu; }
#define XB_SPIN(cond, bar) do { unsigned _sp = 0; while (cond) { __builtin_amdgcn_s_sleep(1); \
    if ((++_sp & 255u) == 0u) { if (xb_ld(&(bar)[XB_TMO])) break; if (_sp > XB_SPIN_CAP) { atomicAdd(&(bar)[XB_TMO], 1u); break; } } } } while (0)

struct XcdBarrier {
    unsigned* bar; unsigned x;
    volatile LAS unsigned* st;
};

__device__ __forceinline__ XcdBarrier xcd_barrier_post(unsigned* bar, volatile LAS unsigned* st) {
    XcdBarrier b; b.bar = bar; b.x = xb_xcc_id(); b.st = st;
    if (threadIdx.x == 0) (void)xb_add(&bar[XB_XCNT(b.x)], 1u);
    return b;
}
__device__ __forceinline__ void xcd_barrier_complete(unsigned* bar, unsigned x, unsigned& nloc, unsigned& nx) {
    const unsigned G = gridDim.x * gridDim.y * gridDim.z;
    unsigned sum, cnt, mine, sp = 0u;
    for (;;) {
        sum = 0u; cnt = 0u; mine = 0u;
#pragma unroll
        for (unsigned j = 0; j < 16; ++j) { const unsigned c = xb_ld(&bar[XB_XCNT(j)]); sum += c; cnt += (c > 0u) ? 1u : 0u; mine = (j == x) ? c : mine; }
        if (sum == G) break;
        __builtin_amdgcn_s_sleep(1);
        if ((++sp & 255u) == 0u) { if (xb_ld(&bar[XB_TMO])) break; if (sp > XB_SPIN_CAP) { atomicAdd(&bar[XB_TMO], 1u); break; } }
    }
    nloc = mine > 0u ? mine : 1u; nx = cnt > 0u ? cnt : 1u;
}

__device__ __forceinline__ void xcd_barrier(const XcdBarrier& b) {
    asm volatile("s_waitcnt vmcnt(0)" ::: "memory");
    __syncthreads();
    if (threadIdx.x == 0) {
        unsigned* bar = b.bar;
        __builtin_amdgcn_s_waitcnt(0);
        unsigned nloc = b.st[0], nx = b.st[1];
        if (nloc == 0u) { xcd_barrier_complete(bar, b.x, nloc, nx); b.st[0] = nloc; b.st[1] = nx; }
        const unsigned old = xb_add(&bar[XB_XSUB(b.x)], 1u);
        const unsigned gen = old / nloc;
        if (old + 1u == (gen + 1u) * nloc) {
            __builtin_amdgcn_fence(__ATOMIC_RELEASE, "agent");
            asm volatile("s_waitcnt vmcnt(0)" ::: "memory");
            const unsigned og = xb_add(&bar[XB_TOP], 1u);
            const unsigned tg = og / nx;
            if (og + 1u == (tg + 1u) * nx) xb_add(&bar[XB_TOPGEN], 1u);
            else XB_SPIN(xb_ld(&bar[XB_TOPGEN]) == tg, bar);
            __builtin_amdgcn_fence(__ATOMIC_ACQUIRE, "agent");
            xb_add(&bar[XB_XGEN(b.x)], 1u);
            asm volatile("s_waitcnt vmcnt(0)" ::: "memory");
        } else {
            XB_SPIN(xb_ld(&bar[XB_XGEN(b.x)]) == gen, bar);
            __builtin_amdgcn_fence(__ATOMIC_ACQUIRE, "agent");
            asm volatile("s_waitcnt vmcnt(0)" ::: "memory");
        }
    }
    __syncthreads();
}


#ifdef TIMING
constexpr size_t WS_TS = 55 * MiB + 4096;
#define TSTAMP(k) do { if (blockIdx.x == 0 && threadIdx.x == 0) { const unsigned long long t1_ = __builtin_amdgcn_s_memrealtime(); unsigned long long* ts_ = (unsigned long long*)(ws0 + WS_TS); ts_[k] += t1_ - ts_[15]; ts_[15] = t1_; } } while (0)
#else
#define TSTAMP(k) do {} while (0)
#endif
__global__ void __launch_bounds__(512, 2) mega_fwd(Params P) {
    extern __shared__ __attribute__((aligned(16))) unsigned char lds_raw[];
    LAS unsigned char* lds = (LAS unsigned char*)lds_raw;
    cg::grid_group grid = cg::this_grid();
    { volatile LAS unsigned* st_ = (volatile LAS unsigned*)(lds + 131072); if (threadIdx.x < 2) st_[threadIdx.x] = 0u; }
    __syncthreads();
    (void)xcd_barrier_post((unsigned*)(P.ws + WS_BAR), (volatile LAS unsigned*)(lds + 131072));
#define GBAR() do { XcdBarrier b_; b_.bar = (unsigned*)(hide_ptr(P.ws) + WS_BAR); b_.x = xb_xcc_id(); b_.st = (volatile LAS unsigned*)(lds + 131072); xcd_barrier(b_); } while (0)
    const int tid0 = threadIdx.x;
    const int G = gridDim.x; const int NGW = G * 8;
    unsigned char* ws0 = P.ws;
    float* hbuf0 = P.out;
#ifdef TIMING
    if (blockIdx.x == 0 && threadIdx.x == 0) { unsigned long long* ts_ = (unsigned long long*)(ws0 + WS_TS); for (int k_ = 0; k_ < 15; ++k_) ts_[k_] = 0ull; ts_[15] = __builtin_amdgcn_s_memrealtime(); }
#endif

#if (PHMASK >> 0) & 1
    _Pragma("unroll 1") for (int rep0_ = 0; rep0_ < 1 + (DUPMASK & 1); ++rep0_)
    { const int L = 0; HIDE_WS
        LAS float* scr = (LAS float*)(lds + wave * 16384);
        constexpr int I_IN = 16 * (NIN / 32), I_UQ = 6 * 24, I_UKV = 4 * 32, I_OUT = 16 * 32, I_FF1 = 16 * 128, I_FF2 = 64 * 32, I_GATE = 16 * 32, I_PROJ = 4 * 32;
        constexpr int I_LAYER = I_IN + I_UQ + I_UKV + I_OUT + I_FF1 + I_FF2 + I_GATE + I_PROJ;
        for (int it = gw; it < 2 * I_LAYER; it += NGW) {
            const int LL = it / I_LAYER; int r = it - LL * I_LAYER; unsigned char* wl = ws + (size_t)LL * WL_STRIDE;
            if (r < I_IN) { wconv_item(P.in[8] + (size_t)LL * 1024 * 2208, 1024, 2208, NIN, 1, P.in[7] + LL * 1024, (bf16_t*)(wl + WL_IN), scr, r, lane); continue; } r -= I_IN;
            if (r < I_UQ) { wconv_item(P.in[10] + (size_t)LL * 384 * 768, 384, 768, 768, 2, P.in[9] + LL * 384, (bf16_t*)(wl + WL_UQ), scr, r, lane); continue; } r -= I_UQ;
            if (r < I_UKV) { wconv_item(P.in[12] + (size_t)LL * 256 * 1024, 256, 1024, 1024, 3, nullptr, (bf16_t*)(wl + WL_UKV), scr, r, lane); continue; } r -= I_UKV;
            if (r < I_OUT) { wconv_item(P.in[14] + (size_t)LL * 1024 * 1024, 1024, 1024, 1024, 0, nullptr, (bf16_t*)(wl + WL_OUT), scr, r, lane); continue; } r -= I_OUT;
            if (r < I_FF1) { wconv_item(P.in[16] + (size_t)LL * 1024 * 4096, 1024, 4096, 4096, 0, P.in[15] + LL * 1024, (bf16_t*)(wl + WL_FF1), scr, r, lane); continue; } r -= I_FF1;
            if (r < I_FF2) { wconv_item(P.in[17] + (size_t)LL * 4096 * 1024, 4096, 1024, 1024, 0, nullptr, (bf16_t*)(wl + WL_FF2), scr, r, lane); continue; } r -= I_FF2;
            if (r < I_GATE) { wconv_item(P.in[19] + (size_t)LL * 1024 * 1024, 1024, 1024, 1024, 0, P.in[18] + LL * 1024, (bf16_t*)(wl + WL_GATE), scr, r, lane); continue; } r -= I_GATE;
            wconv_item(P.in[20] + (size_t)LL * 256 * 1024, 256, 1024, 1024, 0, nullptr, (bf16_t*)(wl + WL_PROJ), scr, r, lane);
        }
        for (int i = blockIdx.x * 512 + tid; i < SEQ * 16; i += G * 512) { const int pos = i >> 4, j = i & 15;
            const double inv = exp2(-(double)j * 0.83048202372184059); const double ang = (double)pos * inv;
            const double kq = rint(ang * 0.15915494309189535); const float rr = (float)(ang - kq * 6.2831853071795865);
            ((f32x2*)(ws + WS_TAB))[i] = (f32x2){cosf(rr), sinf(rr)}; }
        for (int i = blockIdx.x * 512 + tid; i < 6 * MT; i += G * 512) ((float*)(ws + WS_SSQ))[i] = 0.f;
        for (int row = gw; row < MT; row += NGW)
            norm_row_bf16(row < MP ? P.in[0] + (size_t)row * 1024 : P.in[1] + (size_t)(row - MP) * 1024, (bf16_t*)(ws + WS_A) + (size_t)row * 1024, lane);
    }
#endif
    GBAR(); TSTAMP(0);
    if (P.out == nullptr) grid.sync();
#ifdef XSYNC
    for (int xs_ = 0; xs_ < XSYNC; ++xs_) grid.sync();
#endif

#pragma unroll 1
    for (int L = 0; L < 2; ++L) {
#if (PHMASK >> 1) & 1
        { HIDE_WS
        _Pragma("unroll 1") for (int rep_ = 0; rep_ < 1 + ((DUPMASK >> 1) & 1); ++rep_) { asm volatile("" ::: "memory");
        { EpiIn E{(bf16_t*)(ws + WS_RAW), (bf16_t*)(ws + WS_RVG), L == 0 ? nullptr : (const float*)(ws + WS_SSQ) + (size_t)2 * MT}; GEMM_PHASE(EpiIn, E, L == 0 ? (const void*)(ws + WS_A) : (const void*)((const bf16_t*)hbuf + (size_t)MT * 1024), wl + WL_IN, MT, NIN, 1024); }
        }
        }
#endif
        GBAR(); TSTAMP(1);
#if (PHMASK >> 2) & 1
        { HIDE_WS
        _Pragma("unroll 1") for (int rep_ = 0; rep_ < 1 + ((DUPMASK >> 2) & 1); ++rep_) { asm volatile("" ::: "memory");
        for (int row = gw; row < MT; row += NGW) rowpass2(P, L, row, lane);
        for (int cr = gw; cr < NDB * PAST; cr += NGW) cache_row(P, L, cr, lane);
        }
        }
#endif
        GBAR(); TSTAMP(2);
#if (PHMASK >> 3) & 1
        { HIDE_WS
        _Pragma("unroll 1") for (int rep_ = 0; rep_ < 1 + ((DUPMASK >> 3) & 1); ++rep_) { asm volatile("" ::: "memory");
#ifndef NO_UQ
        { EpiUq E{(bf16_t*)(ws + WS_Q), (const float*)(ws + WS_TAB)}; GEMM_PHASE(EpiUq, E, ws + WS_QL, wl + WL_UQ, MT, 768, 384); }
#endif
#ifndef NO_UKV
        { EpiUkv E{(bf16_t*)(ws + WS_KNOPE), (bf16_t*)(ws + WS_V)}; GEMM_PHASE(EpiUkv, E, ws + WS_CKV, wl + WL_UKV, KR - 256, 1024, 256); }
        __syncthreads();
        { MiniArgs ma{(const bf16_t*)(ws + WS_CKV), (const bf16_t*)(wl + WL_UKV), 1024, 256, 4, nullptr, nullptr, nullptr, nullptr, nullptr, (bf16_t*)(ws + WS_KNOPE), nullptr, KR - 256, (bf16_t*)(ws + WS_V)}; mini_gemm(ma, lds, G); }
#endif
        __syncthreads();
#ifndef NO_RKV
        for (int item = gw; item < NITEM; item += NGW) ret_kv_item(item, (const bf16_t*)(ws + WS_RK), (const bf16_t*)(ws + WS_RVG), (float*)(ws + WS_KVT), lds + wave * 12288, lane);
#endif
        }
        }
#endif
        GBAR(); TSTAMP(3);
#if defined(DBG_STOP) && DBG_STOP == 3
        return;
#endif
#if (PHMASK >> 4) & 1
        { HIDE_WS
        _Pragma("unroll 1") for (int rep_ = 0; rep_ < 1 + ((DUPMASK >> 4) & 1); ++rep_) { asm volatile("" ::: "memory");
        _Pragma("unroll 1") for (int r1_ = 0; r1_ < 1 + DUP_SCAN; ++r1_)
        for (int blk = blockIdx.x; blk < 128 + 256; blk += G) { if (blk < 128) ret_scan_prompt(P, L, blk * 512 + tid); else ret_scan_sample(P, L, (blk - 128) * 512 + tid); }
        __syncthreads();
        {
            const bf16_t* Q = (const bf16_t*)(ws + WS_Q); const bf16_t* KN = (const bf16_t*)(ws + WS_KNOPE); const bf16_t* KRB = (const bf16_t*)(ws + WS_KRB);
            const bf16_t* V = (const bf16_t*)(ws + WS_V); bf16_t* MIX = (bf16_t*)(ws + WS_MIX);
#ifndef NO_PROMPT
            _Pragma("unroll 1") for (int r2_ = 0; r2_ < 1 + DUP_PROMPT; ++r2_)
            if (G == 256) { const int vcu = (blockIdx.x % 8) * 32 + blockIdx.x / 8; const int s = vcu & 7, bh = vcu >> 3;
                for (int i = 0; i < 4; ++i) { const int qb = (i == 0) ? 31 - s : (i == 1) ? 16 + s : (i == 2) ? 15 - s : s; att::prompt_unit(bh >> 3, bh & 7, qb, Q, KN, KRB, V, MIX, lds); } }
            else { for (int u = blockIdx.x; u < 1024; u += G) att::prompt_unit((u >> 5) >> 3, (u >> 5) & 7, 31 - (u & 31), Q, KN, KRB, V, MIX, lds); }
#endif
#ifndef NO_SAMPLE
            _Pragma("unroll 1") for (int r3_ = 0; r3_ < 1 + DUP_SAMPLE; ++r3_)
            for (int u = G - 1 - blockIdx.x; u < 64; u += G) att::sample_unit(u >> 3, u & 7, Q, KN, KRB, V, MIX, lds);
#endif
        }
        }
        }
#endif
        GBAR(); TSTAMP(4);
#if defined(DBG_STOP) && DBG_STOP == 4
        return;
#endif
#if (PHMASK >> 5) & 1
        { HIDE_WS
        _Pragma("unroll 1") for (int rep_ = 0; rep_ < 1 + ((DUPMASK >> 5) & 1); ++rep_) { asm volatile("" ::: "memory");
        for (int item = gw; item < NITEM; item += NGW) ret_out_item(P, L, item, lds + wave * 8192, lane);
        for (int i = blockIdx.x * 512 + tid; i < MT * 32; i += G * 512) { const int row = i >> 5, c8 = (i & 31) * 8;
            const float* src = (row < MP ? P.in[5] + ((size_t)L * MP + row) * 256 : P.in[6] + ((size_t)L * MS + (row - MP)) * 256) + c8;
            const f32x4 a = *(const f32x4*)src, b = *(const f32x4*)(src + 4);
            u32x4 w; w.x = cvtpk(a[0], a[1]); w.y = cvtpk(a[2], a[3]); w.z = cvtpk(b[0], b[1]); w.w = cvtpk(b[2], b[3]);
            *(u32x4*)((bf16_t*)(ws + WS_PBF) + (size_t)row * 256 + c8) = w; }
        }
        }
#endif
        GBAR(); TSTAMP(5);
#if (PHMASK >> 6) & 1
        { HIDE_WS
        float* ssq = (float*)(ws + WS_SSQ) + (size_t)L * 3 * MT; bf16_t* HB0 = (bf16_t*)hbuf; const bf16_t* HB1 = (const bf16_t*)hbuf + (size_t)MT * 1024;
        { EpiRes2 E{L == 0 ? P.in[0] : nullptr, HB1, HB0, ssq}; GEMM_PHASE(EpiRes2, E, ws + WS_MIX, wl + WL_OUT, MP, 1024, 1024); }
        { EpiBf E{(bf16_t*)(ws + WS_PG), 1024, 0, nullptr}; GEMM_PHASE(EpiBf, E, ws + WS_PBF, wl + WL_PROJ, MP, 1024, 256); }
        __syncthreads();
        { MiniArgs ma{(const bf16_t*)(ws + WS_PBF), (const bf16_t*)(wl + WL_PROJ), 1024, 256, 3, nullptr, nullptr, nullptr, nullptr, nullptr, (bf16_t*)(ws + WS_PG), nullptr, 0, nullptr}; mini_gemm(ma, lds, G); }
        __syncthreads();
        { MiniArgs ma{(const bf16_t*)(ws + WS_MIX), (const bf16_t*)(wl + WL_OUT), 1024, 1024, 0, L == 0 ? P.in[1] : nullptr, HB1, HB0, ssq, nullptr, nullptr, nullptr, 0, nullptr}; mini_gemm(ma, lds, G); }
        }
#endif
        GBAR(); TSTAMP(6);
#if (PHMASK >> 8) & 1
        { HIDE_WS
        const float* ssq = (const float*)(ws + WS_SSQ) + (size_t)L * 3 * MT; const bf16_t* HB0 = (const bf16_t*)hbuf;
        { EpiBf E{(bf16_t*)(ws + WS_U), DFF, 1, ssq}; GEMM_PHASE(EpiBf, E, HB0, wl + WL_FF1, MP, DFF, 1024); }
        __syncthreads();
        { MiniArgs ma{HB0, (const bf16_t*)(wl + WL_FF1), DFF, 1024, 1, nullptr, nullptr, nullptr, nullptr, ssq, (bf16_t*)(ws + WS_U), nullptr, 0, nullptr}; mini_gemm(ma, lds, G); }
        }
#endif
        GBAR(); TSTAMP(8);
#if (PHMASK >> 9) & 1
        { HIDE_WS
        float* ssq = (float*)(ws + WS_SSQ) + (size_t)(L * 3 + 1) * MT; bf16_t* HB0 = (bf16_t*)hbuf;
        { EpiRes2 E{nullptr, HB0, HB0, ssq}; GEMM_PHASE(EpiRes2, E, ws + WS_U, wl + WL_FF2, MP, 1024, DFF); }
        __syncthreads();
        { MiniArgs ma{(const bf16_t*)(ws + WS_U), (const bf16_t*)(wl + WL_FF2), 1024, DFF, 0, nullptr, HB0, HB0, ssq, nullptr, nullptr, nullptr, 0, nullptr}; mini_gemm(ma, lds, G); }
        }
#endif
        GBAR(); TSTAMP(9);
#if (PHMASK >> 11) & 1
        { HIDE_WS
        const float* ssq_in = (const float*)(ws + WS_SSQ) + (size_t)(L * 3 + 1) * MT; float* ssq_out = (float*)(ws + WS_SSQ) + (size_t)(L * 3 + 2) * MT;
        const bf16_t* HB0 = (const bf16_t*)hbuf; bf16_t* HO = L == 0 ? (bf16_t*)hbuf + (size_t)MT * 1024 : (bf16_t*)(ws + WS_A);
        { EpiGate2 E{HB0, (const bf16_t*)(ws + WS_PG), ssq_in, HO, ssq_out}; GEMM_PHASE(EpiGate2, E, HB0, wl + WL_GATE, MP, 1024, 1024); }
        __syncthreads();
        { MiniArgs ma{HB0, (const bf16_t*)(wl + WL_GATE), 1024, 1024, 2, nullptr, HB0, HO, ssq_out, ssq_in, nullptr, (const bf16_t*)(ws + WS_PG), 0, nullptr}; mini_gemm(ma, lds, G); }
        }
#endif
        GBAR(); TSTAMP(11);
#if (PHMASK >> 12) & 1
        { HIDE_WS
        if (L == 1) { for (int row = gw; row < MT; row += NGW) final_norm_row_bf((const bf16_t*)(ws + WS_A) + (size_t)row * 1024, hbuf + (size_t)row * 1024, P.in[21], lane); }
        }
#endif
        TSTAMP(12);
    }

}


#ifdef SELFCHK
__global__ void __launch_bounds__(512) chk_kernel(Params P) {
    const int gtid = blockIdx.x * 512 + threadIdx.x;
#if DBG_STOP == 3
    chk_after_ph3(P, gtid);
#elif DBG_STOP == 4
    chk_after_ph4(P, gtid);
#endif
}
__global__ void __launch_bounds__(512) enc_kernel(Params P) {
    const float* acc = (const float*)(P.ws + WS_DBG); unsigned code = 0;
    for (int k = 0; k < 6; ++k) { const float e2 = acc[2 * k], r2 = acc[2 * k + 1];
        if (r2 > 0.f && !(e2 <= SELFCHK_TOL * r2)) code |= 1u << k; }
    const float V = sqrtf((float)code);
    for (size_t i = (size_t)blockIdx.x * 512 + threadIdx.x; i < O_END; i += (size_t)gridDim.x * 512) P.out[i] = (i >= (size_t)MP * 1024 && i < (size_t)MT * 1024) ? V : 0.f;
}
#endif
#ifdef DBG_ZERO
__global__ void __launch_bounds__(512) zero_kernel(Params P) {
    {
        const size_t offs[9] = {O_Y, (size_t)MP * 1024, O_CKVP, O_KRP, O_RETP, O_CKVS, O_KRS, O_RETS, O_END};
        for (int k = 0; k < 8; ++k) {
            const size_t a = offs[k], b = offs[k + 1], mid = a + (b - a) / 2;
            size_t z0 = a, z1 = a;
            if ((DBG_ZERO >> k) & 1) { z0 = a; z1 = b; }
            else if (((DBG_ZERO >> 8) & 1) && k >= 2) { z0 = mid; z1 = b; }
            for (size_t i = z0 + (size_t)blockIdx.x * 512 + threadIdx.x; i < z1; i += (size_t)gridDim.x * 512) P.out[i] = 0.f;
#ifdef DBG_NEG
            if (k == DBG_NEG) for (size_t i = a + (size_t)blockIdx.x * 512 + threadIdx.x; i < mid; i += (size_t)gridDim.x * 512) P.out[i] = DBG_NEGF * P.out[i];
#endif
        }
    }
}
#endif

#ifdef TIMING
__global__ void __launch_bounds__(512) tenc_kernel(Params P) {
    const unsigned long long* ts = (const unsigned long long*)(P.ws + 55 * MiB + 4096);
    double tot = 0, sa = 0, sb = 0;
    for (int k = 0; k < 13; ++k) { const double d = (double)ts[k]; tot += d; if ((TIMING_A >> k) & 1) sa += d; if ((TIMING_B >> k) & 1) sb += d; }
    const float V = sqrtf(rintf((float)(98.0 * sa / tot))); const float W = 10.f * (10.f + rintf((float)(89.0 * sb / tot))) + 1.5f;
    for (size_t i = (size_t)blockIdx.x * 512 + threadIdx.x; i < O_END; i += (size_t)gridDim.x * 512) P.out[i] = (i >= (size_t)MP * 1024 && i < (size_t)MT * 1024) ? V : (i == 0 ? W : 0.f);
}
#endif
extern "C" void kernel_launch(void* const* d_in, const int* in_sizes, int n_in, void* d_out, int out_size, void* d_ws, size_t ws_size, hipStream_t stream) {
    static int grid = 0;
    if (grid == 0) {
        if (n_in != 22 || (size_t)out_size != O_END || ws_size < WS_END) { fprintf(stderr, "kernel_launch: unexpected shapes n_in %d out %d ws %zu\n", n_in, out_size, ws_size); grid = -1; return; }
        int dev = 0, cus = 0, per_cu = 0;
        (void)hipGetDevice(&dev); (void)hipDeviceGetAttribute(&cus, hipDeviceAttributeMultiprocessorCount, dev);
        (void)hipFuncSetAttribute((const void*)mega_fwd, hipFuncAttributeMaxDynamicSharedMemorySize, LDS_BYTES);
        if (hipOccupancyMaxActiveBlocksPerMultiprocessor(&per_cu, (const void*)mega_fwd, 512, LDS_BYTES) != hipSuccess || per_cu < 1) { fprintf(stderr, "kernel_launch: occupancy query gave %d\n", per_cu); per_cu = 1; }
        (void)hipGetLastError();
        grid = cus;
        if (grid <= 0) grid = 256;
    }
    if (grid < 0) return;
    Params p{};
    for (int i = 0; i < 22; ++i) p.in[i] = (const float*)d_in[i];
    p.out = (float*)d_out; p.ws = (unsigned char*)d_ws;
    void* args[] = {&p};
    (void)hipMemsetAsync((unsigned char*)d_ws + WS_BAR, 0, XCD_BAR_WORDS * 4, stream);
#ifdef SELFCHK
    (void)hipMemsetAsync((unsigned char*)d_ws + WS_DBG, 0, 256, stream);
#endif
    hipError_t e = hipLaunchCooperativeKernel((const void*)mega_fwd, dim3(grid), dim3(512), args, LDS_BYTES, stream);
    if (e != hipSuccess) fprintf(stderr, "kernel_launch: cooperative launch failed: %s (grid %d)\n", hipGetErrorString(e), grid);
#ifdef TIMING
    hipLaunchKernelGGL(tenc_kernel, dim3(256), dim3(512), 0, stream, p);
#endif
#ifdef DBG_ZERO
    hipLaunchKernelGGL(zero_kernel, dim3(256), dim3(512), 0, stream, p);
#endif
#ifdef SELFCHK
    hipLaunchKernelGGL(chk_kernel, dim3(8), dim3(512), 0, stream, p);
    hipLaunchKernelGGL(enc_kernel, dim3(256), dim3(512), 0, stream, p);
#endif
}
```
